# Optimizing an MI355X kernel written in HIP

```python
import jax
import jax.numpy as jnp
from jax import lax
import numpy as np

D_MODEL = 1024
BATCH = 4
SEQ = 4096
DEPTH = 4

CTX_LEN = 256
GRID_W = 64
N_MIXERS = 3
HEAD_DIM = 64
N_HEADS = D_MODEL // HEAD_DIM
N_KV_HEADS = max(1, N_HEADS // 4)
NA_WIN_H = 8
NA_WIN_W = 16
NA_QCOLS = 16
NA_KCOLS = NA_QCOLS + NA_WIN_W
SWA_RADIUS = 128
Q_BLOCK = 128
ROPE_THETA = 10000.0
D_FF = ((8 * D_MODEL // 3 + 127) // 128) * 128
CONV_W = 3
RMS_EPS = 1e-6
NEG_INF = -1e30
N_LAYERS_NA = (DEPTH + N_MIXERS - 1) // N_MIXERS
N_LAYERS_SWA = (DEPTH + N_MIXERS - 2) // N_MIXERS
N_LAYERS_GA = (DEPTH + N_MIXERS - 3) // N_MIXERS

kernel_name = 'hybrid_na_swa_axial_gqa_convffn_trunk'


def rmsnorm(x, g):
    x32 = x.astype(jnp.float32)
    y = x32 * lax.rsqrt(jnp.mean(x32 * x32, axis=-1, keepdims=True) + RMS_EPS)
    return (y * g.astype(jnp.float32)).astype(x.dtype)


def modulate(h, shift, scale):
    return h * (1 + scale) + shift


def axial_rope_tables(seq):
    t = jnp.arange(seq)
    row = (t // GRID_W).astype(jnp.float32)
    col = (t % GRID_W).astype(jnp.float32)
    n_axis = HEAD_DIM // 4
    inv = ROPE_THETA ** (-jnp.arange(n_axis, dtype=jnp.float32) / n_axis)
    ang = jnp.concatenate([row[:, None] * inv, col[:, None] * inv], axis=-1)
    return jnp.cos(ang), jnp.sin(ang)


def apply_rope(x, cos, sin):
    shp = (x.shape[1],) + (1,) * (x.ndim - 3) + (x.shape[-1] // 2,)
    cos = cos.reshape(shp).astype(x.dtype)
    sin = sin.reshape(shp).astype(x.dtype)
    x1, x2 = jnp.split(x, 2, axis=-1)
    return jnp.concatenate([x1 * cos - x2 * sin, x2 * cos + x1 * sin], axis=-1)


def attend(q, k, v, bias=None, mask=None, sink=None):
    s = jnp.einsum('...qngd,...knd->...ngqk', q, k).astype(jnp.float32) * (HEAD_DIM ** -0.5)
    if bias is not None:
        s = s + bias.astype(jnp.float32)
    if mask is not None:
        s = jnp.where(mask, s, NEG_INF)
    if sink is not None:
        sink_col = jnp.broadcast_to(sink.astype(jnp.float32)[:, :, None, None], s.shape[:-1] + (1,))
        s = jnp.concatenate([s, sink_col], axis=-1)
    p = jax.nn.softmax(s, axis=-1)
    if sink is not None:
        p = p[..., :-1]
    return jnp.einsum('...ngqk,...knd->...qngd', p.astype(v.dtype), v)


def attn_inputs(h, w_qkv, g_q, g_k, n_kv, with_q=True):
    bsz, t = h.shape[:2]
    kv_w = n_kv * HEAD_DIM
    if with_q:
        y = h @ w_qkv
        q = rmsnorm(y[..., :D_MODEL].reshape(bsz, t, n_kv, N_HEADS // n_kv, HEAD_DIM), g_q)
        kv = y[..., D_MODEL:]
    else:
        q = None
        kv = h @ w_qkv[:, D_MODEL:]
    k = rmsnorm(kv[..., :kv_w].reshape(bsz, t, n_kv, HEAD_DIM), g_k)
    v = kv[..., kv_w:].reshape(bsz, t, n_kv, HEAD_DIM)
    return q, k, v


def neighbourhood_attention(q, k, v, k_c, v_c, rpb):
    bsz, seq = q.shape[:2]
    n_ctx = k_c.shape[1]
    rows = seq // GRID_W
    kh = min(NA_WIN_H, rows)
    ncb = GRID_W // NA_QCOLS
    qg = q.reshape(bsz, rows, ncb, NA_QCOLS, N_HEADS, 1, HEAD_DIM)
    kg = k.reshape(bsz, rows, GRID_W, N_HEADS, HEAD_DIM)
    vg = v.reshape(bsz, rows, GRID_W, N_HEADS, HEAD_DIM)
    qcol = np.arange(GRID_W).reshape(ncb, NA_QCOLS)
    kcs = np.clip(np.arange(ncb) * NA_QCOLS - NA_WIN_W // 2, 0, GRID_W - NA_KCOLS)
    kcol = kcs[:, None] + np.arange(NA_KCOLS)
    cs = np.clip(qcol - NA_WIN_W // 2, 0, GRID_W - NA_WIN_W)
    col_ok = (kcol[:, None, :] >= cs[..., None]) & (kcol[:, None, :] < cs[..., None] + NA_WIN_W)
    dc_idx = np.clip(kcol[:, None, :] - qcol[..., None], -(NA_WIN_W - 1), NA_WIN_W - 1) + NA_WIN_W - 1
    lat_ok = np.broadcast_to(col_ok[:, :, None, :], (ncb, NA_QCOLS, kh, NA_KCOLS)).reshape(ncb, NA_QCOLS, kh * NA_KCOLS)
    mask = np.concatenate([lat_ok, np.ones((ncb, NA_QCOLS, n_ctx), bool)], axis=-1)[:, None, None]
    k_cb = jnp.broadcast_to(k_c[:, None], (bsz, ncb) + k_c.shape[1:])
    v_cb = jnp.broadcast_to(v_c[:, None], (bsz, ncb) + v_c.shape[1:])
    zero_ctx_bias = jnp.zeros((ncb, N_HEADS, NA_QCOLS, n_ctx), rpb.dtype)

    def row_step(r):
        rs = jnp.clip(r - kh // 2, 0, rows - kh)
        k_r = lax.dynamic_slice_in_dim(kg, rs, kh, axis=1)
        v_r = lax.dynamic_slice_in_dim(vg, rs, kh, axis=1)
        k_b = jnp.moveaxis(k_r[:, :, kcol], 1, 2).reshape(bsz, ncb, kh * NA_KCOLS, N_HEADS, HEAD_DIM)
        v_b = jnp.moveaxis(v_r[:, :, kcol], 1, 2).reshape(bsz, ncb, kh * NA_KCOLS, N_HEADS, HEAD_DIM)
        k_cat = jnp.concatenate([k_b, k_cb], axis=2)
        v_cat = jnp.concatenate([v_b, v_cb], axis=2)
        dr_idx = rs + jnp.arange(kh) - r + NA_WIN_H - 1
        b_lat = rpb[:, dr_idx[:, None, None, None], dc_idx[None]]
        b_lat = jnp.transpose(b_lat, (2, 0, 3, 1, 4)).reshape(ncb, N_HEADS, NA_QCOLS, kh * NA_KCOLS)
        bias = jnp.concatenate([b_lat, zero_ctx_bias], axis=-1)[:, :, None]
        q_r = lax.dynamic_index_in_dim(qg, r, axis=1, keepdims=False)
        return attend(q_r, k_cat, v_cat, bias=bias, mask=mask)

    out = lax.map(row_step, jnp.arange(rows))
    return jnp.moveaxis(out, 0, 1).reshape(bsz, seq, D_MODEL)


def sliding_window_attention(q, k, v, k_c, v_c, sink):
    bsz, seq = q.shape[:2]
    n_ctx = k_c.shape[1]
    nb = seq // Q_BLOCK
    span = Q_BLOCK + 2 * SWA_RADIUS
    pad = ((0, 0), (SWA_RADIUS, SWA_RADIUS), (0, 0), (0, 0))
    k_p = jnp.pad(k, pad)
    v_p = jnp.pad(v, pad)
    qoff = np.arange(Q_BLOCK)
    koff = np.arange(span) - SWA_RADIUS
    band = np.abs(qoff[:, None] - koff[None, :]) <= SWA_RADIUS
    ctx_ok = jnp.ones((Q_BLOCK, n_ctx), bool)

    def block_step(j):
        start = j * Q_BLOCK
        q_j = lax.dynamic_slice_in_dim(q, start, Q_BLOCK, axis=1)
        k_j = lax.dynamic_slice_in_dim(k_p, start, span, axis=1)
        v_j = lax.dynamic_slice_in_dim(v_p, start, span, axis=1)
        kpos = start - SWA_RADIUS + jnp.arange(span)
        valid = band & ((kpos >= 0) & (kpos < seq))[None, :]
        mask = jnp.concatenate([valid, ctx_ok], axis=-1)
        return attend(q_j, jnp.concatenate([k_j, k_c], axis=1), jnp.concatenate([v_j, v_c], axis=1),
                      mask=mask, sink=sink)

    out = lax.map(block_step, jnp.arange(nb))
    return jnp.moveaxis(out, 0, 1).reshape(bsz, seq, D_MODEL)


def blocked_global_attention(q, k, v, k_c, v_c):
    bsz, seq = q.shape[:2]
    nb = seq // Q_BLOCK
    k_all = jnp.concatenate([k, k_c], axis=1)
    v_all = jnp.concatenate([v, v_c], axis=1)

    def block_step(j):
        q_j = lax.dynamic_slice_in_dim(q, j * Q_BLOCK, Q_BLOCK, axis=1)
        return attend(q_j, k_all, v_all)

    out = lax.map(block_step, jnp.arange(nb))
    return jnp.moveaxis(out, 0, 1).reshape(bsz, seq, D_MODEL)


def conv_ffn(h, w_up, conv_w, conv_b, w_down):
    t = h.shape[1]
    u = h @ w_up
    u_p = jnp.pad(u, ((0, 0), (CONV_W // 2, CONV_W // 2), (0, 0)))
    u = sum(u_p[:, tap:tap + t] * conv_w[tap] for tap in range(CONV_W)) + conv_b
    a, g = jnp.split(u, 2, axis=-1)
    return (a * jax.nn.silu(g)) @ w_down


def setup_inputs(seed: int = 0) -> dict:
    key = jax.random.key(seed)
    ks = iter(jax.random.split(key, 32))
    d = D_MODEL
    qkv_na = d + 2 * N_HEADS * HEAD_DIM
    qkv_gqa = d + 2 * N_KV_HEADS * HEAD_DIM

    def nrm(shape, scale):
        return scale * jax.random.normal(next(ks), shape, jnp.float32)

    return {
        'x': nrm((BATCH, SEQ, d), 1.0),
        'c': nrm((BATCH, d), 1.0),
        'ctx': nrm((BATCH, CTX_LEN, d), 1.0),
        'c_ctx': nrm((d,), 1.0),
        'w_mod': nrm((DEPTH, d, 6 * d), 0.5 * d ** -0.5),
        'b_mod': nrm((DEPTH, 6 * d), 0.02),
        'g_attn': 1.0 + nrm((DEPTH, d), 0.02),
        'g_ffn': 1.0 + nrm((DEPTH, d), 0.02),
        'na_w_qkv': nrm((N_LAYERS_NA, d, qkv_na), d ** -0.5),
        'na_g_q': 1.0 + nrm((N_LAYERS_NA, HEAD_DIM), 0.02),
        'na_g_k': 1.0 + nrm((N_LAYERS_NA, HEAD_DIM), 0.02),
        'na_rpb': nrm((N_LAYERS_NA, N_HEADS, 2 * NA_WIN_H - 1, 2 * NA_WIN_W - 1), 0.5),
        'na_w_o': nrm((N_LAYERS_NA, d, d), d ** -0.5),
        'swa_w_qkv': nrm((N_LAYERS_SWA, d, qkv_gqa), d ** -0.5),
        'swa_g_q': 1.0 + nrm((N_LAYERS_SWA, HEAD_DIM), 0.02),
        'swa_g_k': 1.0 + nrm((N_LAYERS_SWA, HEAD_DIM), 0.02),
        'swa_sink': nrm((N_LAYERS_SWA, N_HEADS), 0.5),
        'swa_w_o': nrm((N_LAYERS_SWA, d, d), d ** -0.5),
        'ga_w_qkv': nrm((N_LAYERS_GA, d, qkv_gqa), d ** -0.5),
        'ga_g_q': 1.0 + nrm((N_LAYERS_GA, HEAD_DIM), 0.02),
        'ga_g_k': 1.0 + nrm((N_LAYERS_GA, HEAD_DIM), 0.02),
        'ga_w_o': nrm((N_LAYERS_GA, d, d), d ** -0.5),
        'ffn_w_up': nrm((DEPTH, d, 2 * D_FF), d ** -0.5),
        'ffn_conv_w': nrm((DEPTH, CONV_W, 2 * D_FF), CONV_W ** -0.5),
        'ffn_conv_b': nrm((DEPTH, 2 * D_FF), 0.02),
        'ffn_w_down': nrm((DEPTH, D_FF, d), D_FF ** -0.5),
    }


def reference(x, c, ctx, c_ctx, w_mod, b_mod, g_attn, g_ffn,
              na_w_qkv, na_g_q, na_g_k, na_rpb, na_w_o,
              swa_w_qkv, swa_g_q, swa_g_k, swa_sink, swa_w_o,
              ga_w_qkv, ga_g_q, ga_g_k, ga_w_o,
              ffn_w_up, ffn_conv_w, ffn_conv_b, ffn_w_down):
    bsz, seq = x.shape[:2]
    n_ctx = ctx.shape[1]
    cos, sin = axial_rope_tables(seq)
    silu_c = jax.nn.silu(c)
    silu_cc = jax.nn.silu(c_ctx)
    for i in range(DEPTH):
        last = i == DEPTH - 1
        kind, j = i % N_MIXERS, i // N_MIXERS
        mod = silu_c @ w_mod[i] + b_mod[i]
        mod_c = silu_cc @ w_mod[i] + b_mod[i]
        sh1, sc1, gt1, sh2, sc2, gt2 = jnp.split(mod[:, None, :], 6, axis=-1)
        sh1c, sc1c, gt1c, sh2c, sc2c, gt2c = jnp.split(mod_c, 6, axis=-1)

        h = modulate(rmsnorm(x, g_attn[i]), sh1, sc1)
        hc = modulate(rmsnorm(ctx, g_attn[i]), sh1c, sc1c)
        if kind == 0:
            w_in, w_out, gq, gk, n_kv, sink = na_w_qkv[j], na_w_o[j], na_g_q[j], na_g_k[j], N_HEADS, None
        elif kind == 1:
            w_in, w_out, gq, gk, n_kv = swa_w_qkv[j], swa_w_o[j], swa_g_q[j], swa_g_k[j], N_KV_HEADS
            sink = swa_sink[j].reshape(n_kv, N_HEADS // n_kv)
        else:
            w_in, w_out, gq, gk, n_kv, sink = ga_w_qkv[j], ga_w_o[j], ga_g_q[j], ga_g_k[j], N_KV_HEADS, None
        q, k, v = attn_inputs(h, w_in, gq, gk, n_kv)
        q_c, k_c, v_c = attn_inputs(hc, w_in, gq, gk, n_kv, with_q=not last)
        if kind == 0:
            o = neighbourhood_attention(q, k, v, k_c, v_c, na_rpb[j])
        else:
            q = apply_rope(q, cos, sin)
            k = apply_rope(k, cos, sin)
            if kind == 1:
                o = sliding_window_attention(q, k, v, k_c, v_c, sink)
            else:
                o = blocked_global_attention(q, k, v, k_c, v_c)
        x = x + gt1 * (o @ w_out)
        if not last:
            o_c = attend(q_c, k_c, v_c, sink=sink).reshape(bsz, n_ctx, D_MODEL)
            ctx = ctx + gt1c * (o_c @ w_out)

        h = modulate(rmsnorm(x, g_ffn[i]), sh2, sc2)
        x = x + gt2 * conv_ffn(h, ffn_w_up[i], ffn_conv_w[i], ffn_conv_b[i], ffn_w_down[i])
        if not last:
            hc = modulate(rmsnorm(ctx, g_ffn[i]), sh2c, sc2c)
            ctx = ctx + gt2c * conv_ffn(hc, ffn_w_up[i], ffn_conv_w[i], ffn_conv_b[i], ffn_w_down[i])
    return x
```

```cpp
#include <hip/hip_runtime.h>
#include <hip/hip_cooperative_groups.h>
#include <cstdio>
#include <cstdint>
namespace cg = cooperative_groups;
#ifndef FAST_QKV
#define FAST_QKV 1
#endif
#ifndef FAST_RESID
#define FAST_RESID 1
#endif
#ifndef FAST_UP
#define FAST_UP 1
#endif
#ifndef FAST_ATTN
#define FAST_ATTN 1
#endif

#define LAS __attribute__((address_space(3)))
typedef unsigned short bf16_t;
typedef short bf16x8 __attribute__((ext_vector_type(8)));
typedef float f32x4 __attribute__((ext_vector_type(4)));
typedef unsigned u32x4 __attribute__((ext_vector_type(4)));
typedef unsigned u32x2 __attribute__((ext_vector_type(2)));

constexpr int D = 1024, NB = 4, SEQ = 4096, CTX = 256, DEPTH = 4;
constexpr int MLAT = NB * SEQ, MCTX = NB * CTX, MTOT = MLAT + MCTX;
constexpr int DFF = 2816, NUP = 2 * DFF;
constexpr int NH = 16, HD = 64;
constexpr int KVROWS = SEQ + CTX;
constexpr int NWAVES = 8, NTHREADS = NWAVES * 64;
constexpr float RMS_EPS = 1e-6f;
constexpr float LOG2E = 1.4426950408889634f;
constexpr float C2 = 0.125f * LOG2E;

__host__ __device__ constexpr int kind_of(int l) { return l % 3; }
__host__ __device__ constexpr int kvw_of(int l) { return kind_of(l) == 0 ? 1024 : 256; }
__host__ __device__ constexpr int nqkv_of(int l) { return 1024 + 2 * kvw_of(l); }
__host__ __device__ constexpr size_t wl_size(int l) { return (size_t)nqkv_of(l) * D + (size_t)D * D + (size_t)NUP * D + (size_t)D * DFF; }
__host__ __device__ constexpr size_t wl_off(int l) { size_t o = 0; for (int i = 0; i < l; ++i) o += wl_size(i); return o; }

constexpr size_t MiB = 1u << 20;
constexpr size_t WS_BAR = 16384, WS_CTL_BYTES = 65536;
constexpr size_t WS_MOD = 1 * MiB;
constexpr size_t WS_ROPE = 1 * MiB + 768 * 1024;
constexpr size_t WS_STATS = 6 * MiB;
constexpr size_t WS_BQKV = 7 * MiB + 256 * 1024;
constexpr size_t WS_BUP = 7 * MiB + 512 * 1024;
constexpr size_t WS_CTXRES = 2 * MiB;
constexpr size_t WS_W = 8 * MiB;
constexpr size_t WS_H = 100 * MiB;
constexpr size_t WS_Q = 134 * MiB;
constexpr size_t WS_K = 168 * MiB;
constexpr size_t WS_V = 202 * MiB;
constexpr size_t WS_O = 236 * MiB;
constexpr size_t WS_ACT = 270 * MiB;
constexpr size_t WS_HB = 134 * MiB;
constexpr size_t WS_U = 134 * MiB;
constexpr size_t WS_END = 364 * MiB;
static_assert(WS_W + wl_off(DEPTH) * 2 <= WS_H, "weights fit");
static_assert(WS_U + (size_t)9216 * NUP * 2 <= WS_ACT, "u chunk fits");
static_assert(WS_ACT + (size_t)MTOT * DFF * 2 <= WS_END, "act fits");

struct Params { const float* in[26]; float* out; unsigned char* ws; int ph_lo, ph_hi; };

__device__ __forceinline__ int tid_opaque() { int t = threadIdx.x; asm volatile("" : "+v"(t)); return t; }
__device__ __forceinline__ unsigned f2bf(float f) { unsigned u = __builtin_bit_cast(unsigned, f); return (u + 0x7fffu + ((u >> 16) & 1u)) >> 16; }
__device__ __forceinline__ unsigned pk2(float lo, float hi) { return f2bf(lo) | (f2bf(hi) << 16); }
__device__ __forceinline__ float bf_lo(unsigned w) { return __builtin_bit_cast(float, w << 16); }
__device__ __forceinline__ float bf_hi(unsigned w) { return __builtin_bit_cast(float, w & 0xffff0000u); }
__device__ __forceinline__ float wave_sum(float v) {
#pragma unroll
    for (int o = 1; o < 64; o <<= 1) v += __shfl_xor(v, o);
    return v;
}
__device__ __forceinline__ float silu_f(float x) { return x / (1.f + __expf(-x)); }
__device__ __forceinline__ float* xrow_ptr(const Params& P, int r) { return r < MLAT ? P.out + (size_t)r * D : (float*)(P.ws + WS_CTXRES) + (size_t)(r - MLAT) * D; }
__device__ __forceinline__ int cond_idx(int r) { return r < MLAT ? (r >> 12) : 4; }
__device__ __forceinline__ size_t kv_row(int r) { return r < MLAT ? (size_t)(r >> 12) * KVROWS + (r & 4095) : (size_t)((r - MLAT) >> 8) * KVROWS + SEQ + ((r - MLAT) & 255); }
__device__ __forceinline__ const float* mod_ptr(const Params& P, int l, int ci) { return (const float*)(P.ws + WS_MOD) + (size_t)(l * 5 + ci) * 6144; }

struct LayerW { const float *wqkv, *gq, *gk, *wo, *rpb, *sink; };
__device__ __forceinline__ LayerW layer_w(const Params& P, int l) {
    LayerW w; const int kind = kind_of(l), j = l / 3;
    if (kind == 0) { w.wqkv = P.in[8] + (size_t)j * D * 3072; w.gq = P.in[9] + j * 64; w.gk = P.in[10] + j * 64; w.rpb = P.in[11] + (size_t)j * NH * 15 * 31; w.wo = P.in[12] + (size_t)j * D * D; w.sink = nullptr; }
    else if (kind == 1) { w.wqkv = P.in[13] + (size_t)j * D * 1536; w.gq = P.in[14] + j * 64; w.gk = P.in[15] + j * 64; w.sink = P.in[16] + j * NH; w.wo = P.in[17] + (size_t)j * D * D; w.rpb = nullptr; }
    else { w.wqkv = P.in[18] + (size_t)j * D * 1536; w.gq = P.in[19] + j * 64; w.gk = P.in[20] + j * 64; w.wo = P.in[21] + (size_t)j * D * D; w.rpb = nullptr; w.sink = nullptr; }
    return w;
}
__device__ __forceinline__ bf16_t* wt_qkv(const Params& P, int l) { return (bf16_t*)(P.ws + WS_W) + wl_off(l); }
__device__ __forceinline__ bf16_t* wt_o(const Params& P, int l) { return wt_qkv(P, l) + (size_t)nqkv_of(l) * D; }
__device__ __forceinline__ bf16_t* wt_up(const Params& P, int l) { return wt_o(P, l) + (size_t)D * D; }
__device__ __forceinline__ bf16_t* wt_dn(const Params& P, int l) { return wt_up(P, l) + (size_t)NUP * D; }

__device__ __forceinline__ int phys_qkv(int c) { return (c & ~255) + 128 * ((c >> 5) & 1) + 32 * ((c >> 6) & 3) + (c & 31); }
__device__ __forceinline__ int phys_up(int c) { const int bj = c >= DFF ? 1 : 0, cc = c - bj * DFF; return 256 * (cc >> 7) + 128 * bj + (cc & 127); }

__device__ __forceinline__ void transpose_item(const float* W, int K, int N, bf16_t* WT, int mode, LAS float* scr, int item, int lane) {
    const int nblk = N / 32, kb = item / nblk, nb = item % nblk, k0 = 64 * kb, n0 = 32 * nb;
#pragma unroll 8
    for (int i = 0; i < 32; ++i) { const int kk = 2 * i + (lane >> 5); scr[kk * 33 + (lane & 31)] = W[(size_t)(k0 + kk) * N + n0 + (lane & 31)]; }
    asm volatile("s_waitcnt lgkmcnt(0)" ::: "memory");
    const int p0 = mode == 1 ? phys_qkv(n0) : (mode == 2 ? phys_up(n0) : n0);
    const int c = lane & 7;
#pragma unroll
    for (int j = 0; j < 4; ++j) { const int n = (lane >> 3) + 8 * j; const LAS float* s = scr + (8 * c) * 33 + n;
        u32x4 o; o.x = pk2(s[0 * 33], s[1 * 33]); o.y = pk2(s[2 * 33], s[3 * 33]); o.z = pk2(s[4 * 33], s[5 * 33]); o.w = pk2(s[6 * 33], s[7 * 33]);
        *(u32x4*)(WT + (size_t)(p0 + n) * K + k0 + 8 * c) = o; }
    asm volatile("s_waitcnt lgkmcnt(0)" ::: "memory");
}

template <int L> __device__ __forceinline__ void prologue_weights(const Params& P, LAS float* scr, int gw, int NGW, int lane) {
    const LayerW lw = layer_w(P, L); constexpr int nq = nqkv_of(L);
    constexpr int I_Q = (D / 64) * (nq / 32), I_O = (D / 64) * (D / 32), I_U = (D / 64) * (NUP / 32), I_D = (DFF / 64) * (D / 32);
    constexpr int NIT = I_Q + I_O + I_U + I_D;
    for (int it = gw; it < NIT; it += NGW) {
        int r = it;
        if (r < I_Q) { transpose_item(lw.wqkv, D, nq, wt_qkv(P, L), 1, scr, r, lane); continue; } r -= I_Q;
        if (r < I_O) { transpose_item(lw.wo, D, D, wt_o(P, L), 0, scr, r, lane); continue; } r -= I_O;
        if (r < I_U) { transpose_item(P.in[22] + (size_t)L * D * NUP, D, NUP, wt_up(P, L), 2, scr, r, lane); continue; } r -= I_U;
        transpose_item(P.in[25] + (size_t)L * DFF * D, DFF, D, wt_dn(P, L), 0, scr, r, lane);
    }
}

__device__ __forceinline__ void ph_prologue(const Params& P, LAS unsigned char* lds) {
    const int tid = tid_opaque(), wave = __builtin_amdgcn_readfirstlane(tid >> 6), lane = tid & 63;
    if (blockIdx.x == 0) {
        float* tab = (float*)(P.ws + WS_ROPE);
        for (int idx = tid; idx < 64 * 16; idx += NTHREADS) { const int pos = idx >> 4, f = idx & 15;
            const float inv = powf(10000.0f, -(float)f / 16.0f); const float ang = (float)pos * inv;
            tab[2 * idx] = cosf(ang); tab[2 * idx + 1] = sinf(ang); }
    }
    {
        LAS float* sil = (LAS float*)lds;
        LAS float* part = (LAS float*)(lds + 20480);
        for (int i = tid; i < 5 * 1024; i += NTHREADS) { const int ci = i >> 10, k = i & 1023; const float c = ci < 4 ? P.in[1][ci * D + k] : P.in[3][k]; sil[i] = silu_f(c); }
        __syncthreads();
        for (int it = blockIdx.x; it < DEPTH * 96; it += gridDim.x) {
            const int l = it / 96, n = (it % 96) * 64 + lane;
            const float* w = P.in[4] + (size_t)l * D * 6144 + n;
            float a0 = 0.f, a1 = 0.f, a2 = 0.f, a3 = 0.f, a4 = 0.f;
            const int kbeg = wave * 128;
#pragma unroll 8
            for (int k = kbeg; k < kbeg + 128; ++k) { const float wv = w[(size_t)k * 6144];
                a0 += sil[k] * wv; a1 += sil[1024 + k] * wv; a2 += sil[2048 + k] * wv; a3 += sil[3072 + k] * wv; a4 += sil[4096 + k] * wv; }
            part[(wave * 5 + 0) * 64 + lane] = a0; part[(wave * 5 + 1) * 64 + lane] = a1; part[(wave * 5 + 2) * 64 + lane] = a2; part[(wave * 5 + 3) * 64 + lane] = a3; part[(wave * 5 + 4) * 64 + lane] = a4;
            __syncthreads();
            if (tid < 320) { const int ci = tid >> 6, ln = tid & 63; float s = 0.f;
#pragma unroll
                for (int w8 = 0; w8 < 8; ++w8) s += part[(w8 * 5 + ci) * 64 + ln];
                const int nn = (it % 96) * 64 + ln;
                ((float*)(P.ws + WS_MOD))[(size_t)(l * 5 + ci) * 6144 + nn] = s + P.in[5][l * 6144 + nn]; }
            __syncthreads();
        }
    }
    const int gw = blockIdx.x * NWAVES + wave, NGW = gridDim.x * NWAVES;
    {
        LAS float* scr = (LAS float*)(lds + 32768 + wave * 8704);
        prologue_weights<0>(P, scr, gw, NGW, lane); prologue_weights<1>(P, scr, gw, NGW, lane);
        prologue_weights<2>(P, scr, gw, NGW, lane); prologue_weights<3>(P, scr, gw, NGW, lane);
    }
}


template <int L> __device__ __forceinline__ void prologue_bias(const Params& P, int gw, int NGW, int lane) {
    constexpr int nq = nqkv_of(L), NIT = (nq + NUP) / 8;
    for (int it = gw; it < NIT; it += NGW) {
        const int p0 = it * 8; const bool isq = p0 < nq;
        const bf16_t* W = isq ? wt_qkv(P, L) + (size_t)p0 * D : wt_up(P, L) + (size_t)(p0 - nq) * D;
        float* dst = isq ? (float*)(P.ws + WS_BQKV) + (size_t)L * 5 * 3072 + p0 : (float*)(P.ws + WS_BUP) + (size_t)L * 5 * NUP + (p0 - nq);
        const int dstride = isq ? nq : NUP;
        f32x4 sh[5][4];
#pragma unroll
        for (int ci = 0; ci < 5; ++ci) { const float* sp = mod_ptr(P, L, ci) + (isq ? 0 : 3072) + 16 * lane;
#pragma unroll
            for (int q = 0; q < 4; ++q) sh[ci][q] = *(const f32x4*)(sp + 4 * q); }
        for (int rr = 0; rr < 8; ++rr) {
            const u32x4 w0 = *(const u32x4*)(W + (size_t)rr * D + 16 * lane), w1 = *(const u32x4*)(W + (size_t)rr * D + 16 * lane + 8);
            const f32x4 wf[4] = {(f32x4){bf_lo(w0.x), bf_hi(w0.x), bf_lo(w0.y), bf_hi(w0.y)}, (f32x4){bf_lo(w0.z), bf_hi(w0.z), bf_lo(w0.w), bf_hi(w0.w)},
                                 (f32x4){bf_lo(w1.x), bf_hi(w1.x), bf_lo(w1.y), bf_hi(w1.y)}, (f32x4){bf_lo(w1.z), bf_hi(w1.z), bf_lo(w1.w), bf_hi(w1.w)}};
#pragma unroll
            for (int ci = 0; ci < 5; ++ci) { f32x4 a = sh[ci][0] * wf[0] + sh[ci][1] * wf[1] + sh[ci][2] * wf[2] + sh[ci][3] * wf[3];
                const float t = wave_sum((a.x + a.y) + (a.z + a.w));
                if (lane == 0) dst[(size_t)ci * dstride + rr] = t; }
        }
    }
}

__device__ __forceinline__ void ph_prologue_b(const Params& P) {
    const int tid = tid_opaque(), wave = __builtin_amdgcn_readfirstlane(tid >> 6), lane = tid & 63;
    const int gw = blockIdx.x * NWAVES + wave, NGW = gridDim.x * NWAVES;
    bf16_t* H = (bf16_t*)(P.ws + WS_H); float* stats = (float*)(P.ws + WS_STATS);
    const float* g = P.in[6];
    for (int r = gw; r < MTOT; r += NGW) {
        const f32x4* xs = (r < MLAT ? (const f32x4*)(P.in[0] + (size_t)r * D) : (const f32x4*)(P.in[2] + (size_t)(r - MLAT) * D)) + lane;
        f32x4* xd = (f32x4*)xrow_ptr(P, r) + lane;
        const float* md = mod_ptr(P, 0, cond_idx(r));
        u32x2* o8 = (u32x2*)(H + (size_t)r * D) + lane;
        float ss = 0.f;
#pragma unroll
        for (int j = 0; j < 4; ++j) { const f32x4 v = xs[64 * j]; xd[64 * j] = v; ss += (v.x * v.x + v.y * v.y) + (v.z * v.z + v.w * v.w);
            const int c = 4 * lane + 256 * j; const f32x4 gg = *(const f32x4*)(g + c), sc = *(const f32x4*)(md + 1024 + c);
            const f32x4 hh = v * (gg * (sc + 1.0f)); u32x2 w; w.x = pk2(hh.x, hh.y); w.y = pk2(hh.z, hh.w); o8[64 * j] = w; }
        ss = wave_sum(ss);
        if (lane < 16) stats[(size_t)r * 16 + lane] = lane == 0 ? ss : 0.f;
    }
    prologue_bias<0>(P, gw, NGW, lane); prologue_bias<1>(P, gw, NGW, lane); prologue_bias<2>(P, gw, NGW, lane); prologue_bias<3>(P, gw, NGW, lane);
}

__device__ __forceinline__ void ph_norm(const Params& P, int l, int which, int nrows, int wave, int lane) {
    const int gw = blockIdx.x * NWAVES + wave, NGW = gridDim.x * NWAVES;
    const float* g = (which == 0 ? P.in[6] : P.in[7]) + l * D;
    bf16_t* H = (bf16_t*)(P.ws + WS_H);
    for (int r = gw; r < nrows; r += NGW) {
        const f32x4* xr = (const f32x4*)xrow_ptr(P, r) + lane;
        const float* md = mod_ptr(P, l, cond_idx(r)) + (which == 0 ? 0 : 3072);
        f32x4 v[4]; float s = 0.f;
#pragma unroll
        for (int j = 0; j < 4; ++j) { v[j] = xr[64 * j]; s += (v[j].x * v[j].x + v[j].y * v[j].y) + (v[j].z * v[j].z + v[j].w * v[j].w); }
        const float rstd = 1.0f / sqrtf(wave_sum(s) * (1.f / D) + RMS_EPS);
        u32x2* o8 = (u32x2*)(H + (size_t)r * D) + lane;
#pragma unroll
        for (int j = 0; j < 4; ++j) { const int c = 4 * lane + 256 * j;
            const f32x4 gg = *(const f32x4*)(g + c), sh = *(const f32x4*)(md + c), sc = *(const f32x4*)(md + 1024 + c);
            const f32x4 y = (v[j] * rstd) * gg;
            const f32x4 hh = y * (sc + 1.0f) + sh;
            u32x2 w; w.x = pk2(hh.x, hh.y); w.y = pk2(hh.z, hh.w); o8[64 * j] = w; }
    }
}

__device__ __forceinline__ void wave_gemm(const bf16_t* a0p, const bf16_t* a1p, const bf16_t* b0, const bf16_t* b1, const bf16_t* b2, const bf16_t* b3, int K, f32x4 (&acc)[2][4]) {
#pragma unroll
    for (int m = 0; m < 2; ++m)
#pragma unroll
        for (int n = 0; n < 4; ++n) acc[m][n] = (f32x4){0.f, 0.f, 0.f, 0.f};
#pragma unroll 2
    for (int k = 0; k < K; k += 32) {
        const bf16x8 a0 = *(const bf16x8*)(a0p + k), a1 = *(const bf16x8*)(a1p + k);
        const bf16x8 w0 = *(const bf16x8*)(b0 + k), w1 = *(const bf16x8*)(b1 + k), w2 = *(const bf16x8*)(b2 + k), w3 = *(const bf16x8*)(b3 + k);
        acc[0][0] = __builtin_amdgcn_mfma_f32_16x16x32_bf16(w0, a0, acc[0][0], 0, 0, 0);
        acc[0][1] = __builtin_amdgcn_mfma_f32_16x16x32_bf16(w1, a0, acc[0][1], 0, 0, 0);
        acc[0][2] = __builtin_amdgcn_mfma_f32_16x16x32_bf16(w2, a0, acc[0][2], 0, 0, 0);
        acc[0][3] = __builtin_amdgcn_mfma_f32_16x16x32_bf16(w3, a0, acc[0][3], 0, 0, 0);
        acc[1][0] = __builtin_amdgcn_mfma_f32_16x16x32_bf16(w0, a1, acc[1][0], 0, 0, 0);
        acc[1][1] = __builtin_amdgcn_mfma_f32_16x16x32_bf16(w1, a1, acc[1][1], 0, 0, 0);
        acc[1][2] = __builtin_amdgcn_mfma_f32_16x16x32_bf16(w2, a1, acc[1][2], 0, 0, 0);
        acc[1][3] = __builtin_amdgcn_mfma_f32_16x16x32_bf16(w3, a1, acc[1][3], 0, 0, 0);
    }
}

__device__ __forceinline__ void ph_qkv(const Params& P, int l, int wave, int lane) {
    const int gw = blockIdx.x * NWAVES + wave, NGW = gridDim.x * NWAVES;
    const int kind = kind_of(l), kvw = kvw_of(l), nkvh = kvw / 64, nheads = 16 + 2 * nkvh;
    const bool last = (l == DEPTH - 1);
    const LayerW lw = layer_w(P, l);
    const bf16_t* H = (const bf16_t*)(P.ws + WS_H); const bf16_t* W = wt_qkv(P, l);
    bf16_t* Qb = (bf16_t*)(P.ws + WS_Q); bf16_t* Kb = (bf16_t*)(P.ws + WS_K); bf16_t* Vb = (bf16_t*)(P.ws + WS_V);
    const float* rope = (const float*)(P.ws + WS_ROPE);
    const int fr = lane & 15, fq = lane >> 4;
    const int nitems = (MTOT / 32) * nheads;
    for (int it = gw; it < nitems; it += NGW) {
        const int rb = it / nheads, hh = it % nheads, row0 = rb * 32;
        if (last && row0 >= MLAT && hh < 16) continue;
        const bf16_t* a0p = H + (size_t)(row0 + fr) * D + fq * 8; const bf16_t* a1p = a0p + (size_t)16 * D;
        const bf16_t* bp[4];
#pragma unroll
        for (int nt = 0; nt < 4; ++nt) { const int p = 256 * (hh >> 2) + 128 * (nt >> 1) + 32 * (hh & 3) + 16 * (nt & 1) + fr; bp[nt] = W + (size_t)p * D + fq * 8; }
        f32x4 acc[2][4];
        wave_gemm(a0p, a1p, bp[0], bp[1], bp[2], bp[3], D, acc);
        const int type = hh < 16 ? 0 : (hh < 16 + nkvh ? 1 : 2);
        const int hidx = type == 0 ? hh : (type == 1 ? hh - 16 : hh - 16 - nkvh);
#pragma unroll
        for (int mt = 0; mt < 2; ++mt) {
            const int row = row0 + 16 * mt + fr;
            f32x4 v[4];
#pragma unroll
            for (int nt = 0; nt < 4; ++nt) v[nt] = acc[mt][nt];
            if (type < 2) {
                float ss = 0.f;
#pragma unroll
                for (int nt = 0; nt < 4; ++nt) ss += (v[nt].x * v[nt].x + v[nt].y * v[nt].y) + (v[nt].z * v[nt].z + v[nt].w * v[nt].w);
                ss += __shfl_xor(ss, 16); ss += __shfl_xor(ss, 32);
                const float rinv = 1.0f / sqrtf(ss * (1.f / 64.f) + RMS_EPS);
                const float* gg = type == 0 ? lw.gq : lw.gk;
#pragma unroll
                for (int nt = 0; nt < 4; ++nt) { const f32x4 g4 = *(const f32x4*)(gg + 16 * nt + 4 * fq); v[nt] = (v[nt] * rinv) * g4; }
                if (kind != 0 && row < MLAT) {
                    const int t = row & 4095, prow = t >> 6, pcol = t & 63;
#pragma unroll
                    for (int nt = 0; nt < 2; ++nt) {
                        const float* tb = rope + ((nt == 0 ? prow : pcol) * 16 + 4 * fq) * 2;
                        const f32x4 t0 = *(const f32x4*)tb, t1 = *(const f32x4*)(tb + 4);
                        const f32x4 cs = (f32x4){t0.x, t0.z, t1.x, t1.z}, sn = (f32x4){t0.y, t0.w, t1.y, t1.w};
                        const f32x4 x1 = v[nt], x2 = v[nt + 2];
                        v[nt] = x1 * cs - x2 * sn; v[nt + 2] = x2 * cs + x1 * sn;
                    }
                }
                if (type == 0) {
#pragma unroll
                    for (int nt = 0; nt < 4; ++nt) v[nt] = v[nt] * C2;
                }
            }
            bf16_t* dst;
            if (type == 0) dst = Qb + (size_t)row * D + hidx * 64;
            else dst = (type == 1 ? Kb : Vb) + kv_row(row) * kvw + hidx * 64;
#pragma unroll
            for (int nt = 0; nt < 4; ++nt) { u32x2 w; w.x = pk2(v[nt].x, v[nt].y); w.y = pk2(v[nt].z, v[nt].w); *(u32x2*)(dst + 16 * nt + 4 * fq) = w; }
        }
    }
}

__device__ __forceinline__ void ph_resid_gemm(const Params& P, int l, const bf16_t* A, int K, const bf16_t* W, int gate_off, int nrows, int wave, int lane) {
    const int gw = blockIdx.x * NWAVES + wave, NGW = gridDim.x * NWAVES;
    const int fr = lane & 15, fq = lane >> 4;
    const int nitems = (nrows / 32) * 16;
    for (int it = gw; it < nitems; it += NGW) {
        const int rb = it >> 4, cb = it & 15, row0 = rb * 32, c0 = cb * 64;
        const bf16_t* a0p = A + (size_t)(row0 + fr) * K + fq * 8; const bf16_t* a1p = a0p + (size_t)16 * K;
        const bf16_t* bp = W + (size_t)(c0 + fr) * K + fq * 8;
        f32x4 acc[2][4];
        wave_gemm(a0p, a1p, bp, bp + (size_t)16 * K, bp + (size_t)32 * K, bp + (size_t)48 * K, K, acc);
        const float* gate = mod_ptr(P, l, cond_idx(row0)) + gate_off;
#pragma unroll
        for (int mt = 0; mt < 2; ++mt) { float* xr = xrow_ptr(P, row0 + 16 * mt + fr);
#pragma unroll
            for (int nt = 0; nt < 4; ++nt) { const int c = c0 + 16 * nt + 4 * fq; const f32x4 g4 = *(const f32x4*)(gate + c); f32x4* xp = (f32x4*)(xr + c); *xp = *xp + g4 * acc[mt][nt]; } }
    }
}

__device__ __forceinline__ void ph_up_gemm(const Params& P, int l, int r0, int nrows, int wave, int lane) {
    const int gw = blockIdx.x * NWAVES + wave, NGW = gridDim.x * NWAVES;
    const int fr = lane & 15, fq = lane >> 4;
    const bf16_t* H = (const bf16_t*)(P.ws + WS_H); const bf16_t* W = wt_up(P, l); bf16_t* U = (bf16_t*)(P.ws + WS_U);
    const int nitems = (nrows / 32) * (NUP / 64);
    for (int it = gw; it < nitems; it += NGW) {
        const int rb = it / (NUP / 64), cb = it % (NUP / 64), row0 = r0 + rb * 32, c0 = cb * 64;
        const bf16_t* a0p = H + (size_t)(row0 + fr) * D + fq * 8; const bf16_t* a1p = a0p + (size_t)16 * D;
        const bf16_t* bp = W + (size_t)(c0 + fr) * D + fq * 8;
        f32x4 acc[2][4];
        wave_gemm(a0p, a1p, bp, bp + (size_t)16 * D, bp + (size_t)32 * D, bp + (size_t)48 * D, D, acc);
#pragma unroll
        for (int mt = 0; mt < 2; ++mt) { bf16_t* ur = U + (size_t)(row0 - r0 + 16 * mt + fr) * NUP + c0;
#pragma unroll
            for (int nt = 0; nt < 4; ++nt) { u32x2 w; w.x = pk2(acc[mt][nt].x, acc[mt][nt].y); w.y = pk2(acc[mt][nt].z, acc[mt][nt].w); *(u32x2*)(ur + 16 * nt + 4 * fq) = w; } }
    }
}

__device__ __forceinline__ void ph_conv(const Params& P, int l, int r0, int nrows) {
    const int gt = blockIdx.x * NTHREADS + threadIdx.x, NGT = gridDim.x * NTHREADS;
    const bf16_t* U = (const bf16_t*)(P.ws + WS_U); bf16_t* ACT = (bf16_t*)(P.ws + WS_ACT);
    const float* cw = P.in[23] + (size_t)l * 3 * NUP; const float* cb = P.in[24] + (size_t)l * NUP;
    const int per_row = DFF / 8;
    for (int i = gt; i < nrows * per_row; i += NGT) {
        const int rr = i / per_row, c = (i % per_row) * 8, row = r0 + rr;
        const int pos = row < MLAT ? (row & 4095) : ((row - MLAT) & 255), slen = row < MLAT ? SEQ : CTX;
        const int pa = 256 * (c >> 7) + (c & 127);
        float av[8], gv[8];
#pragma unroll
        for (int e = 0; e < 8; ++e) { av[e] = cb[c + e]; gv[e] = cb[DFF + c + e]; }
#pragma unroll
        for (int tap = 0; tap < 3; ++tap) {
            const int pp = pos + tap - 1;
            if (pp < 0 || pp >= slen) continue;
            const bf16_t* ur = U + (size_t)(rr + tap - 1) * NUP + pa;
            const u32x4 ua = *(const u32x4*)ur, ug = *(const u32x4*)(ur + 128);
            const float* wa = cw + tap * NUP + c; const float* wg = wa + DFF;
            av[0] += wa[0] * bf_lo(ua.x); av[1] += wa[1] * bf_hi(ua.x); av[2] += wa[2] * bf_lo(ua.y); av[3] += wa[3] * bf_hi(ua.y);
            av[4] += wa[4] * bf_lo(ua.z); av[5] += wa[5] * bf_hi(ua.z); av[6] += wa[6] * bf_lo(ua.w); av[7] += wa[7] * bf_hi(ua.w);
            gv[0] += wg[0] * bf_lo(ug.x); gv[1] += wg[1] * bf_hi(ug.x); gv[2] += wg[2] * bf_lo(ug.y); gv[3] += wg[3] * bf_hi(ug.y);
            gv[4] += wg[4] * bf_lo(ug.z); gv[5] += wg[5] * bf_hi(ug.z); gv[6] += wg[6] * bf_lo(ug.w); gv[7] += wg[7] * bf_hi(ug.w);
        }
        u32x4 o;
        o.x = pk2(av[0] * silu_f(gv[0]), av[1] * silu_f(gv[1])); o.y = pk2(av[2] * silu_f(gv[2]), av[3] * silu_f(gv[3]));
        o.z = pk2(av[4] * silu_f(gv[4]), av[5] * silu_f(gv[5])); o.w = pk2(av[6] * silu_f(gv[6]), av[7] * silu_f(gv[7]));
        *(u32x4*)(ACT + (size_t)row * DFF + c) = o;
    }
}

__device__ __forceinline__ void attn_key(const bf16_t* kp, const bf16_t* vp, const unsigned (&q)[32], float (&o)[64], float& m, float& l, bool valid, float bias) {
    float s0 = 0.f, s1 = 0.f;
#pragma unroll
    for (int c = 0; c < 8; ++c) { const u32x4 kk = *(const u32x4*)(kp + 8 * c);
        s0 += bf_lo(q[4 * c + 0]) * bf_lo(kk.x); s1 += bf_hi(q[4 * c + 0]) * bf_hi(kk.x); s0 += bf_lo(q[4 * c + 1]) * bf_lo(kk.y); s1 += bf_hi(q[4 * c + 1]) * bf_hi(kk.y);
        s0 += bf_lo(q[4 * c + 2]) * bf_lo(kk.z); s1 += bf_hi(q[4 * c + 2]) * bf_hi(kk.z); s0 += bf_lo(q[4 * c + 3]) * bf_lo(kk.w); s1 += bf_hi(q[4 * c + 3]) * bf_hi(kk.w); }
    float s = (s0 + s1) + bias; if (!valid) s = -1e30f;
    const float mn = fmaxf(m, s), a = __builtin_amdgcn_exp2f(m - mn), p = __builtin_amdgcn_exp2f(s - mn);
    l = l * a + p; m = mn;
#pragma unroll
    for (int c = 0; c < 8; ++c) { const u32x4 vv = *(const u32x4*)(vp + 8 * c);
        o[8 * c + 0] = o[8 * c + 0] * a + p * bf_lo(vv.x); o[8 * c + 1] = o[8 * c + 1] * a + p * bf_hi(vv.x); o[8 * c + 2] = o[8 * c + 2] * a + p * bf_lo(vv.y); o[8 * c + 3] = o[8 * c + 3] * a + p * bf_hi(vv.y);
        o[8 * c + 4] = o[8 * c + 4] * a + p * bf_lo(vv.z); o[8 * c + 5] = o[8 * c + 5] * a + p * bf_hi(vv.z); o[8 * c + 6] = o[8 * c + 6] * a + p * bf_lo(vv.w); o[8 * c + 7] = o[8 * c + 7] * a + p * bf_hi(vv.w); }
}

__device__ __forceinline__ void ph_attn(const Params& P, int l, int wave, int lane) {
    const int gw = blockIdx.x * NWAVES + wave, NGW = gridDim.x * NWAVES;
    const int kind = kind_of(l), kvw = kvw_of(l);
    const bool last = (l == DEPTH - 1);
    const LayerW lw = layer_w(P, l);
    const bf16_t* Qb = (const bf16_t*)(P.ws + WS_Q); const bf16_t* Kb = (const bf16_t*)(P.ws + WS_K); const bf16_t* Vb = (const bf16_t*)(P.ws + WS_V);
    bf16_t* Ob = (bf16_t*)(P.ws + WS_O);
    const int nrows = last ? MLAT : MTOT;
    const int nitems = (nrows / 64) * NH;
    for (int it = gw; it < nitems; it += NGW) {
        const int h = it & 15, rblk = it >> 4, row0 = rblk * 64, row = row0 + lane;
        const bool isctx = row0 >= MLAT;
        const int b = isctx ? ((row0 - MLAT) >> 8) : (row0 >> 12);
        const int kvh = kind == 0 ? h : (h >> 2);
        const bf16_t* Kbase = Kb + (size_t)b * KVROWS * kvw + kvh * 64; const bf16_t* Vbase = Vb + (size_t)b * KVROWS * kvw + kvh * 64;
        unsigned q[32]; float o[64];
        { const bf16_t* qp = Qb + (size_t)row * D + h * 64;
#pragma unroll
          for (int c = 0; c < 8; ++c) { const u32x4 w = *(const u32x4*)(qp + 8 * c); q[4 * c + 0] = w.x; q[4 * c + 1] = w.y; q[4 * c + 2] = w.z; q[4 * c + 3] = w.w; } }
#pragma unroll
        for (int d = 0; d < 64; ++d) o[d] = 0.f;
        float m = -1e30f, lsum = 0.f;
        for (int j = SEQ; j < KVROWS; ++j) attn_key(Kbase + (size_t)j * kvw, Vbase + (size_t)j * kvw, q, o, m, lsum, true, 0.f);
        if (!isctx) {
            const int t0 = row0 & 4095, t = t0 + lane;
            if (kind == 2) {
                for (int j = 0; j < SEQ; ++j) attn_key(Kbase + (size_t)j * kvw, Vbase + (size_t)j * kvw, q, o, m, lsum, true, 0.f);
            } else if (kind == 1) {
                const int jlo = t0 - 128 < 0 ? 0 : t0 - 128, jhi = t0 + 64 + 128 > SEQ ? SEQ : t0 + 64 + 128;
                for (int j = jlo; j < jhi; ++j) { const int dd = j - t; attn_key(Kbase + (size_t)j * kvw, Vbase + (size_t)j * kvw, q, o, m, lsum, dd >= -128 && dd <= 128, 0.f); }
            } else {
                const int r = t0 >> 6, c = lane;
                int rs = r - 4; rs = rs < 0 ? 0 : (rs > 56 ? 56 : rs);
                int cs = c - 8; cs = cs < 0 ? 0 : (cs > 48 ? 48 : cs);
                const float* rp = lw.rpb + (size_t)h * 15 * 31;
                for (int kr = rs; kr < rs + 8; ++kr) {
                    const float* rrow = rp + (kr - r + 7) * 31;
                    for (int kc = 0; kc < 64; ++kc) {
                        const bool valid = (kc >= cs) && (kc < cs + 16);
                        int dc = kc - c; dc = dc < -15 ? -15 : (dc > 15 ? 15 : dc);
                        const float bias = rrow[dc + 15] * LOG2E;
                        const int j = kr * 64 + kc;
                        attn_key(Kbase + (size_t)j * kvw, Vbase + (size_t)j * kvw, q, o, m, lsum, valid, bias);
                    }
                }
            }
        }
        if (kind == 1) lsum += __builtin_amdgcn_exp2f(lw.sink[h] * LOG2E - m);
        const float inv = 1.0f / lsum;
        bf16_t* op = Ob + (size_t)row * D + h * 64;
#pragma unroll
        for (int c = 0; c < 8; ++c) { u32x4 w; w.x = pk2(o[8 * c + 0] * inv, o[8 * c + 1] * inv); w.y = pk2(o[8 * c + 2] * inv, o[8 * c + 3] * inv); w.z = pk2(o[8 * c + 4] * inv, o[8 * c + 5] * inv); w.w = pk2(o[8 * c + 6] * inv, o[8 * c + 7] * inv);
            *(u32x4*)(op + 8 * c) = w; }
    }
}

namespace pg8 {
#define PG8_LAS __attribute__((address_space(3)))
typedef unsigned short bf16_t;
typedef short bf16x8 __attribute__((ext_vector_type(8)));
typedef float f32x4 __attribute__((ext_vector_type(4)));
typedef unsigned u32x4 __attribute__((ext_vector_type(4)));
constexpr int BM = 256, BK = 64, HALF = 128, HTB = HALF * BK * 2  , STAGE_BYTES = 8 * HTB, NXCD = 8, WGM = 8;

__host__ __device__ __forceinline__ int lds_byte(int r, int c) { const int st = (r >> 4) * 2 + (c >> 5), rr = r & 15, cc = c & 31, ob = rr * 64 + cc * 2; return st * 1024 + (ob ^ (((ob >> 9) & 1) << 5)); }
__host__ __device__ __forceinline__ void stage_rc(int b, int& R, int& C) { const int st = b / 1024, sb = b % 1024, swz = sb ^ (((sb >> 9) & 1) << 5); R = (st >> 1) * 16 + swz / 64; C = (st & 1) * 32 + (swz % 64) / 2; }
__host__ __device__ __forceinline__ int perm32(int rho) { const int n = rho >> 4, i = rho & 15; return 8 * (i >> 2) + 4 * n + (i & 3); }

struct Unit { int pm, pn; };
struct Gemm { const bf16_t* A; const bf16_t* Bt; int M, N, K; };

struct StaticOrder {
    int nM, nN, nwg, G, c;
    __host__ __device__ void init(int M, int N, int G_, int c_) { nM = M / BM; nN = N / BM; nwg = nM * nN; G = G_; c = c_; }
    __host__ __device__ bool next(int i, Unit& u) const {
        const long L = (long)i * G + c; if (L >= nwg) return false;
        int wgid = (int)L; { const int q = nwg / NXCD, r = nwg % NXCD, xcd = wgid % NXCD, off = wgid / NXCD; wgid = (xcd < r ? xcd * (q + 1) : r * (q + 1) + (xcd - r) * q) + off; }
        const int nig = WGM * nN, gid = wgid / nig, fm = gid * WGM, gsz = (nM - fm) < WGM ? (nM - fm) : WGM;
        u.pm = fm + ((wgid % nig) % gsz); u.pn = (wgid % nig) / gsz; return true;
    }
    __device__ __forceinline__ void a_ready(const Unit&) const {}
    __device__ __forceinline__ void done(const Unit&) const {}
};
template <class Epi, class Sched, bool ALIGN_EPI = false, bool SP2 = false>
__device__ __forceinline__ void gemm_phase(PG8_LAS unsigned char* lds, const Gemm g, const Sched& S, const Epi& E) {
    const int tid = tid_opaque(), wid = __builtin_amdgcn_readfirstlane(tid >> 6), lane = tid & 63, wr = wid >> 2, wc = wid & 3, fr = lane & 15, fq = lane >> 4;
    const int K = g.K, nt = K / BK;
    unsigned voffA[2], voffB[2];
#pragma unroll
    for (int i = 0; i < 2; ++i) { int R, C; stage_rc(tid * 16 + i * 8192, R, C); const int Rb = Epi::PERM ? ((R & ~31) + perm32(R & 31)) : R;
        voffA[i] = (unsigned)(R * K + C) * 2u; voffB[i] = (unsigned)(Rb * K + C) * 2u; }
    const size_t kstep = (size_t)(BK * 2);
    const size_t hstep = (size_t)HALF * K * 2;
    const size_t tstep = 2 * hstep;
    const unsigned ldsw = (unsigned)wid * 1024u;
    const int aoff = lds_byte(wr * 64 + fr, fq * 8), boff = lds_byte(wc * 32 + fr, fq * 8);
#define PG8_SA(b, h) (((b) * 2 + (h)) * HTB)
#define PG8_SB(b, h) ((4 + (b) * 2 + (h)) * HTB)
#define PG8_STAGE(bufoff, gbase, voff) do { _Pragma("unroll") for (int _i = 0; _i < 2; ++_i) \
        __builtin_amdgcn_global_load_lds((const unsigned*)((const char*)(gbase) + (voff)[_i]), (PG8_LAS unsigned*)(lds + (bufoff) + ldsw + _i * 8192), 16, 0, 0); } while (0)
#define PG8_LDA(dst, b, h) do { _Pragma("unroll") for (int m = 0; m < 4; ++m) _Pragma("unroll") for (int k = 0; k < 2; ++k) dst[m][k] = *(const PG8_LAS bf16x8*)(lds + PG8_SA(b, h) + aoff + m * 2048 + k * 1024); } while (0)
#define PG8_LDB(dst, b, h) do { _Pragma("unroll") for (int n = 0; n < 2; ++n) _Pragma("unroll") for (int k = 0; k < 2; ++k) dst[n][k] = *(const PG8_LAS bf16x8*)(lds + PG8_SB(b, h) + boff + n * 2048 + k * 1024); } while (0)
#define PG8_MMA(ai, bj, At, Bt) do { __builtin_amdgcn_s_setprio(1); _Pragma("unroll") for (int m = 0; m < 4; ++m) _Pragma("unroll") for (int n = 0; n < 2; ++n) _Pragma("unroll") for (int k = 0; k < 2; ++k) \
        acc[ai][bj][m][n] = __builtin_amdgcn_mfma_f32_16x16x32_bf16(Bt[n][k], At[m][k], acc[ai][bj][m][n], 0, 0, 0); __builtin_amdgcn_s_setprio(0); } while (0)
#define PG8_WAIT_V(n) asm volatile("s_waitcnt vmcnt(" #n ")" ::: "memory")
#define PG8_WAIT_L(n) asm volatile("s_waitcnt lgkmcnt(" #n ")" ::: "memory")
#define PG8_BAR __builtin_amdgcn_s_barrier()
#define PG8_SCHED __builtin_amdgcn_sched_barrier(0)
    Unit cur, nxt; int ui = 0;
    if (!S.next(0, cur)) return;
    f32x4 acc[2][2][4][2];
#pragma unroll
    for (int a = 0; a < 2; ++a)
#pragma unroll
        for (int b = 0; b < 2; ++b)
#pragma unroll
            for (int m = 0; m < 4; ++m)
#pragma unroll
                for (int n = 0; n < 2; ++n) acc[a][b][m][n] = (f32x4){0.f, 0.f, 0.f, 0.f};
    bf16x8 At[4][2], B0[2][2], B1[2][2];
    const char* cA = (const char*)g.A + (size_t)cur.pm * tstep; const char* cB = (const char*)g.Bt + (size_t)cur.pn * tstep;
    S.a_ready(cur);
    if constexpr (SP2) {
        PG8_STAGE(PG8_SB(0, 0), cB, voffB); PG8_STAGE(PG8_SB(0, 1), cB + hstep, voffB); PG8_STAGE(PG8_SA(0, 0), cA, voffA); PG8_STAGE(PG8_SA(0, 1), cA + hstep, voffA);
        if (wr == 1) PG8_BAR;
        PG8_WAIT_V(2); PG8_BAR;
        PG8_STAGE(PG8_SB(1, 0), cB + kstep, voffB); PG8_STAGE(PG8_SA(1, 0), cA + kstep, voffA); PG8_STAGE(PG8_SB(1, 1), cB + hstep + kstep, voffB);
        PG8_WAIT_V(6); PG8_BAR;
    } else {
        PG8_STAGE(PG8_SB(0, 0), cB, voffB); PG8_STAGE(PG8_SA(0, 0), cA, voffA); PG8_STAGE(PG8_SB(0, 1), cB + hstep, voffB); PG8_STAGE(PG8_SA(0, 1), cA + hstep, voffA);
        if (wr == 1) PG8_BAR;
        PG8_WAIT_V(4); PG8_BAR;
        PG8_STAGE(PG8_SB(1, 0), cB + kstep, voffB); PG8_STAGE(PG8_SA(1, 0), cA + kstep, voffA); PG8_STAGE(PG8_SB(1, 1), cB + hstep + kstep, voffB);
        PG8_WAIT_V(6); PG8_BAR;
    }
    for (;;) {
        const bool has_next = S.next(ui + 1, nxt);
        const char* nA = has_next ? (const char*)g.A + (size_t)nxt.pm * tstep : cA; const char* nB = has_next ? (const char*)g.Bt + (size_t)nxt.pn * tstep : cB;
        for (int t = 0; t < nt; t += 2) {
            const bool last = (t == nt - 2);
            const char* a1 = cA + (size_t)(t + 1) * kstep;
            const char* a2 = last ? nA : cA + (size_t)(t + 2) * kstep; const char* b2 = last ? nB : cB + (size_t)(t + 2) * kstep;
            const char* a3 = a2 + kstep; const char* b3 = b2 + kstep;
            if (last && has_next) S.a_ready(nxt);
            if constexpr (SP2) {
            PG8_LDB(B0, 0, 0); PG8_LDB(B1, 0, 1); PG8_SCHED; PG8_LDA(At, 0, 0); PG8_STAGE(PG8_SA(1, 1), a1 + hstep, voffA);
            PG8_WAIT_V(8); PG8_WAIT_L(0); PG8_BAR; PG8_MMA(0, 0, At, B0); PG8_MMA(0, 1, At, B1); PG8_BAR; PG8_SCHED;
            PG8_LDA(At, 0, 1); PG8_STAGE(PG8_SB(0, 0), b2, voffB); PG8_STAGE(PG8_SB(0, 1), b2 + hstep, voffB); PG8_STAGE(PG8_SA(0, 0), a2, voffA);
            PG8_WAIT_V(8); PG8_WAIT_L(0); PG8_BAR; PG8_MMA(1, 0, At, B0); PG8_MMA(1, 1, At, B1); PG8_BAR; PG8_SCHED;
            PG8_LDB(B0, 1, 0); PG8_LDB(B1, 1, 1); PG8_SCHED; PG8_LDA(At, 1, 0); PG8_STAGE(PG8_SA(0, 1), a2 + hstep, voffA);
            PG8_WAIT_V(8); PG8_WAIT_L(0); PG8_BAR; PG8_MMA(0, 0, At, B0); PG8_MMA(0, 1, At, B1); PG8_BAR; PG8_SCHED;
            PG8_LDA(At, 1, 1); PG8_STAGE(PG8_SB(1, 0), b3, voffB); PG8_STAGE(PG8_SB(1, 1), b3 + hstep, voffB); PG8_STAGE(PG8_SA(1, 0), a3, voffA);
            PG8_WAIT_V(8); PG8_WAIT_L(0); PG8_BAR; PG8_MMA(1, 0, At, B0); PG8_MMA(1, 1, At, B1); PG8_BAR; PG8_SCHED;
            } else {
            PG8_LDB(B0, 0, 0); PG8_SCHED; PG8_LDA(At, 0, 0); PG8_STAGE(PG8_SA(1, 1), a1 + hstep, voffA);
            PG8_WAIT_L(8); PG8_BAR; PG8_WAIT_L(0); PG8_MMA(0, 0, At, B0); PG8_BAR; PG8_SCHED;
            PG8_LDB(B1, 0, 1); PG8_STAGE(PG8_SB(0, 0), b2, voffB);
            PG8_BAR; PG8_WAIT_L(0); PG8_MMA(0, 1, At, B1); PG8_BAR;
            PG8_LDA(At, 0, 1); PG8_STAGE(PG8_SA(0, 0), a2, voffA);
            PG8_BAR; PG8_WAIT_L(0); PG8_MMA(1, 0, At, B0); PG8_BAR; PG8_SCHED;
            PG8_STAGE(PG8_SB(0, 1), b2 + hstep, voffB);
            PG8_WAIT_V(6); PG8_BAR; PG8_MMA(1, 1, At, B1); PG8_BAR;
            PG8_LDB(B0, 1, 0); PG8_SCHED; PG8_LDA(At, 1, 0); PG8_STAGE(PG8_SA(0, 1), a2 + hstep, voffA);
            PG8_WAIT_L(8); PG8_BAR; PG8_WAIT_L(0); PG8_MMA(0, 0, At, B0); PG8_BAR; PG8_SCHED;
            PG8_LDB(B1, 1, 1); PG8_STAGE(PG8_SB(1, 0), b3, voffB);
            PG8_BAR; PG8_WAIT_L(0); PG8_MMA(0, 1, At, B1); PG8_BAR;
            PG8_LDA(At, 1, 1); PG8_STAGE(PG8_SA(1, 0), a3, voffA);
            PG8_BAR; PG8_WAIT_L(0); PG8_MMA(1, 0, At, B0); PG8_BAR; PG8_SCHED;
            PG8_STAGE(PG8_SB(1, 1), b3 + hstep, voffB);
            PG8_WAIT_V(6); PG8_BAR; PG8_MMA(1, 1, At, B1); PG8_BAR;
            }
        }
        if constexpr (ALIGN_EPI) { if (wr == 0) PG8_BAR; }
        if constexpr (!Epi::AFTER_DRAIN) { E(acc, cur, wr, wc, fr, fq); S.done(cur); }
        if (!has_next) break;
#pragma unroll
        for (int a = 0; a < 2; ++a)
#pragma unroll
            for (int b = 0; b < 2; ++b)
#pragma unroll
                for (int m = 0; m < 4; ++m)
#pragma unroll
                    for (int n = 0; n < 2; ++n) acc[a][b][m][n] = (f32x4){0.f, 0.f, 0.f, 0.f};
        cur = nxt; cA = nA; cB = nB; ++ui;
        if constexpr (ALIGN_EPI) { if (wr == 1) PG8_BAR; }
    }
    PG8_WAIT_V(0);
    if constexpr (!ALIGN_EPI) { if (wr == 0) PG8_BAR; }
    PG8_BAR;
    if constexpr (Epi::AFTER_DRAIN) { E.fused(acc, cur, wr, wc, fr, fq, lds, wid, lane); S.done(cur); }
#undef PG8_SA
#undef PG8_SB
#undef PG8_STAGE
#undef PG8_LDA
#undef PG8_LDB
#undef PG8_MMA
#undef PG8_WAIT_V
#undef PG8_WAIT_L
#undef PG8_BAR
#undef PG8_SCHED
}
}

#ifndef PG8_SP2
#define PG8_SP2 true
#endif
#ifndef PG8_ALIGN
#define PG8_ALIGN true
#endif

__device__ __forceinline__ unsigned cvt_pk_bf16(float lo, float hi) { unsigned r; asm volatile("v_cvt_pk_bf16_f32 %0, %1, %2" : "=v"(r) : "v"(lo), "v"(hi)); return r; }


__device__ __forceinline__ void row_rstd(const float* stats, int row0, int fq, float (&rstd)[2][4]) {
#pragma unroll
    for (int ai = 0; ai < 2; ++ai) {
        f32x4 p[4];
#pragma unroll
        for (int m = 0; m < 4; ++m) p[m] = *(const f32x4*)(stats + (size_t)(row0 + 128 * ai + 16 * m) * 16 + 4 * fq);
#pragma unroll
        for (int m = 0; m < 4; ++m) { float s = (p[m].x + p[m].y) + (p[m].z + p[m].w); s += __shfl_xor(s, 16); s += __shfl_xor(s, 32);
            rstd[ai][m] = 1.0f / sqrtf(s * (1.f / D) + RMS_EPS); }
        asm volatile("" ::: "memory");
    }
}

template <int L> struct EpiQKV {
    static constexpr bool PERM = true, AFTER_DRAIN = false;
    bf16_t *Q, *K, *V; const float *gq, *gk, *rope, *stats, *bias;
    __device__ __forceinline__ void operator()(const f32x4 (&acc)[2][2][4][2], const pg8::Unit& u, int wr, int wc, int fr, int fq) const {
        constexpr int kind = kind_of(L), kvw = kvw_of(L), nkvh = kvw / 64; constexpr bool last = (L == DEPTH - 1);
        const int hh = 4 * u.pn + wc;
        const int type = hh < 16 ? 0 : (hh < 16 + nkvh ? 1 : 2);
        const int hidx = type == 0 ? hh : (type == 1 ? hh - 16 : hh - 16 - nkvh);
        if (last && u.pm >= 64 && type == 0) return;
        const float* gg = type == 0 ? gq : gk;
        f32x4 g4[2][2], b4[2][2];
        const int ci = u.pm < 64 ? (u.pm >> 4) : 4;
        const float* bp = bias + (size_t)ci * nqkv_of(L) + 256 * u.pn + 32 * wc + 8 * fq;
#pragma unroll
        for (int bj = 0; bj < 2; ++bj)
#pragma unroll
            for (int n = 0; n < 2; ++n) { g4[bj][n] = *(const f32x4*)(gg + 32 * bj + 8 * fq + 4 * n); b4[bj][n] = *(const f32x4*)(bp + 128 * bj + 4 * n); }
        float rstd[2][4];
        row_rstd(stats, 256 * u.pm + 64 * wr + fr, fq, rstd);
#pragma unroll
        for (int ai = 0; ai < 2; ++ai)
#pragma unroll
            for (int m = 0; m < 4; ++m) {
                const int row = 256 * u.pm + 128 * ai + 64 * wr + 16 * m + fr;
                f32x4 v[2][2];
#pragma unroll
                for (int bj = 0; bj < 2; ++bj)
#pragma unroll
                    for (int n = 0; n < 2; ++n) v[bj][n] = acc[ai][bj][m][n] * rstd[ai][m] + b4[bj][n];
                if (type < 2) {
                    float ss = 0.f;
#pragma unroll
                    for (int bj = 0; bj < 2; ++bj)
#pragma unroll
                        for (int n = 0; n < 2; ++n) ss += (v[bj][n].x * v[bj][n].x + v[bj][n].y * v[bj][n].y) + (v[bj][n].z * v[bj][n].z + v[bj][n].w * v[bj][n].w);
                    ss += __shfl_xor(ss, 16); ss += __shfl_xor(ss, 32);
                    const float rinv = 1.0f / sqrtf(ss * (1.f / 64.f) + RMS_EPS);
#pragma unroll
                    for (int bj = 0; bj < 2; ++bj)
#pragma unroll
                        for (int n = 0; n < 2; ++n) v[bj][n] = (v[bj][n] * rinv) * g4[bj][n];
                    if (kind != 0 && u.pm < 64) {
                        const int t = row & 4095, pos = fq < 2 ? (t >> 6) : (t & 63);
#pragma unroll
                        for (int n = 0; n < 2; ++n) {
                            const float* tb = rope + (pos * 16 + 8 * (fq & 1) + 4 * n) * 2;
                            const f32x4 t0 = *(const f32x4*)tb, t1 = *(const f32x4*)(tb + 4);
                            const f32x4 cs = (f32x4){t0.x, t0.z, t1.x, t1.z}, sn = (f32x4){t0.y, t0.w, t1.y, t1.w};
                            const f32x4 x1 = v[0][n], x2 = v[1][n];
                            v[0][n] = x1 * cs - x2 * sn; v[1][n] = x2 * cs + x1 * sn;
                        }
                    }
                    if (type == 0) {
#pragma unroll
                        for (int bj = 0; bj < 2; ++bj)
#pragma unroll
                            for (int n = 0; n < 2; ++n) v[bj][n] = v[bj][n] * C2;
                    }
                }
                bf16_t* dst;
                if (type == 0) dst = Q + (size_t)row * D + hidx * 64;
                else dst = (type == 1 ? K : V) + kv_row(row) * kvw + hidx * 64;
#pragma unroll
                for (int bj = 0; bj < 2; ++bj) { u32x4 w; w.x = cvt_pk_bf16(v[bj][0].x, v[bj][0].y); w.y = cvt_pk_bf16(v[bj][0].z, v[bj][0].w); w.z = cvt_pk_bf16(v[bj][1].x, v[bj][1].y); w.w = cvt_pk_bf16(v[bj][1].z, v[bj][1].w);
                    *(u32x4*)(dst + 32 * bj + 8 * fq) = w; }
            }
    }
};

struct EpiResid {
    static constexpr bool PERM = true, AFTER_DRAIN = false;
    float* lat; float* ctx; const float* gate_l;
    bf16_t* H; float* stats; const float* gn; const float* scn;
    __device__ __forceinline__ void operator()(const f32x4 (&acc)[2][2][4][2], const pg8::Unit& u, int wr, int wc, int fr, int fq) const {
        const int ci = u.pm < 64 ? (u.pm >> 4) : 4;
        const int col0 = 256 * u.pn + 32 * wc + 8 * fq;
        const float* gate = gate_l + (size_t)ci * 6144 + col0;
        float* xb = (u.pm < 64 ? lat + (size_t)(256 * u.pm) * D : ctx + (size_t)(256 * (u.pm - 64)) * D) + col0;
        const bool emit = gn != nullptr;
        float ss[2][4];
#pragma unroll
        for (int ai = 0; ai < 2; ++ai)
#pragma unroll
            for (int m = 0; m < 4; ++m) ss[ai][m] = 0.f;
#pragma unroll
        for (int bj = 0; bj < 2; ++bj) {
            f32x4 g4[2], G4[2];
#pragma unroll
            for (int n = 0; n < 2; ++n) { g4[n] = *(const f32x4*)(gate + 128 * bj + 4 * n);
                if (emit) G4[n] = *(const f32x4*)(gn + col0 + 128 * bj + 4 * n) * (*(const f32x4*)(scn + (size_t)ci * 6144 + col0 + 128 * bj + 4 * n) + 1.0f);
                else G4[n] = (f32x4){0.f, 0.f, 0.f, 0.f}; }
#pragma unroll
            for (int ai = 0; ai < 2; ++ai)
#pragma unroll
                for (int m = 0; m < 4; ++m) { const int rl = 128 * ai + 64 * wr + 16 * m + fr; float* rowp = xb + (size_t)rl * D + 128 * bj; f32x4 xn[2];
#pragma unroll
                    for (int n = 0; n < 2; ++n) { f32x4* xp = (f32x4*)(rowp + 4 * n); xn[n] = *xp + g4[n] * acc[ai][bj][m][n]; *xp = xn[n];
                        ss[ai][m] += (xn[n].x * xn[n].x + xn[n].y * xn[n].y) + (xn[n].z * xn[n].z + xn[n].w * xn[n].w); }
                    if (emit) { const f32x4 h0 = xn[0] * G4[0], h1 = xn[1] * G4[1];
                        u32x4 w; w.x = cvt_pk_bf16(h0.x, h0.y); w.y = cvt_pk_bf16(h0.z, h0.w); w.z = cvt_pk_bf16(h1.x, h1.y); w.w = cvt_pk_bf16(h1.z, h1.w);
                        *(u32x4*)(H + (size_t)(256 * u.pm + rl) * D + col0 + 128 * bj) = w; }
                    if (m & 1) asm volatile("" ::: "memory"); }
        }
        if (emit) {
#pragma unroll
            for (int ai = 0; ai < 2; ++ai)
#pragma unroll
                for (int m = 0; m < 4; ++m) { float t = ss[ai][m]; t += __shfl_xor(t, 16); t += __shfl_xor(t, 32);
                    if (fq == 0) stats[(size_t)(256 * u.pm + 128 * ai + 64 * wr + 16 * m + fr) * 16 + 4 * u.pn + wc] = t; }
        }
    }
};

struct EpiStore {
    static constexpr bool PERM = true, AFTER_DRAIN = false;
    bf16_t* O; int ldc;
    __device__ __forceinline__ void operator()(const f32x4 (&acc)[2][2][4][2], const pg8::Unit& u, int wr, int wc, int fr, int fq) const {
        bf16_t* base = O + (size_t)(256 * u.pm + 64 * wr + fr) * ldc + 256 * u.pn + 32 * wc + 8 * fq;
#pragma unroll
        for (int ai = 0; ai < 2; ++ai)
#pragma unroll
            for (int m = 0; m < 4; ++m) { bf16_t* rowp = base + (size_t)(128 * ai + 16 * m) * ldc;
#pragma unroll
                for (int bj = 0; bj < 2; ++bj) { const f32x4 v0 = acc[ai][bj][m][0], v1 = acc[ai][bj][m][1];
                    u32x4 w; w.x = cvt_pk_bf16(v0.x, v0.y); w.y = cvt_pk_bf16(v0.z, v0.w); w.z = cvt_pk_bf16(v1.x, v1.y); w.w = cvt_pk_bf16(v1.z, v1.w);
                    *(u32x4*)(rowp + 128 * bj) = w; } }
    }
};


__device__ __forceinline__ float dpp_up(float cur, float prevblk) {
    const int old = __builtin_amdgcn_update_dpp(0, __builtin_bit_cast(int, prevblk), 0x121  , 0xf, 0xf, true);
    return __builtin_bit_cast(float, __builtin_amdgcn_update_dpp(old, __builtin_bit_cast(int, cur), 0x111  , 0xf, 0xf, false));
}
__device__ __forceinline__ float dpp_dn(float cur, float nextblk) {
    const int old = __builtin_amdgcn_update_dpp(0, __builtin_bit_cast(int, nextblk), 0x12F  , 0xf, 0xf, true);
    return __builtin_bit_cast(float, __builtin_amdgcn_update_dpp(old, __builtin_bit_cast(int, cur), 0x101  , 0xf, 0xf, false));
}
struct EpiUpConv {
    static constexpr bool PERM = true, AFTER_DRAIN = false;
    bf16_t* ACT; float* HB; const float* cw; const float* cb;
    const float* stats; const float* bias;
    __device__ __forceinline__ void operator()(f32x4 (&acc)[2][2][4][2], const pg8::Unit& u, int wr, int wc, int fr, int fq) const {
        const int ca = 128 * u.pn + 32 * wc + 8 * fq;
        { const int ci = u.pm < 64 ? (u.pm >> 4) : 4;
          const float* bp = bias + (size_t)ci * NUP + 256 * u.pn + 32 * wc + 8 * fq;
          float rstd[2][4];
          row_rstd(stats, 256 * u.pm + 64 * wr + fr, fq, rstd);
#pragma unroll
          for (int bj = 0; bj < 2; ++bj)
#pragma unroll
              for (int n = 0; n < 2; ++n) { const f32x4 b4 = *(const f32x4*)(bp + 128 * bj + 4 * n);
#pragma unroll
                  for (int ai = 0; ai < 2; ++ai)
#pragma unroll
                      for (int m = 0; m < 4; ++m) acc[ai][bj][m][n] = acc[ai][bj][m][n] * rstd[ai][m] + b4; } }
        unsigned outp[2][4][2][2];
#pragma unroll
        for (int n = 0; n < 2; ++n) {
            f32x4 wa[3], wg[3];
#pragma unroll
            for (int tap = 0; tap < 3; ++tap) { wa[tap] = *(const f32x4*)(cw + tap * NUP + ca + 4 * n); wg[tap] = *(const f32x4*)(cw + tap * NUP + DFF + ca + 4 * n); }
            const f32x4 ba = *(const f32x4*)(cb + ca + 4 * n), bg = *(const f32x4*)(cb + DFF + ca + 4 * n);
#pragma unroll
            for (int ai = 0; ai < 2; ++ai)
#pragma unroll
                for (int m = 0; m < 4; ++m) {
                    const f32x4 z = (f32x4){0.f, 0.f, 0.f, 0.f};
                    const f32x4 A = acc[ai][0][m][n], G = acc[ai][1][m][n];
                    const f32x4 Ap = m > 0 ? acc[ai][0][m - 1][n] : z, An = m < 3 ? acc[ai][0][m + 1][n] : z;
                    const f32x4 Gp = m > 0 ? acc[ai][1][m - 1][n] : z, Gn = m < 3 ? acc[ai][1][m + 1][n] : z;
                    float r[4];
#pragma unroll
                    for (int i = 0; i < 4; ++i) {
                        const float av = ba[i] + wa[0][i] * dpp_up(A[i], Ap[i]) + wa[1][i] * A[i] + wa[2][i] * dpp_dn(A[i], An[i]);
                        const float gv = bg[i] + wg[0][i] * dpp_up(G[i], Gp[i]) + wg[1][i] * G[i] + wg[2][i] * dpp_dn(G[i], Gn[i]);
                        r[i] = av * gv * __builtin_amdgcn_rcpf(1.0f + __builtin_amdgcn_exp2f(-LOG2E * gv));
                    }
                    outp[ai][m][n][0] = cvt_pk_bf16(r[0], r[1]); outp[ai][m][n][1] = cvt_pk_bf16(r[2], r[3]);
                }
        }
        const int row0 = 256 * u.pm + 64 * wr + fr;
#pragma unroll
        for (int ai = 0; ai < 2; ++ai)
#pragma unroll
            for (int m = 0; m < 4; ++m) { u32x4 w; w.x = outp[ai][m][0][0]; w.y = outp[ai][m][0][1]; w.z = outp[ai][m][1][0]; w.w = outp[ai][m][1][1];
                *(u32x4*)(ACT + (size_t)(row0 + 128 * ai + 16 * m) * DFF + ca) = w; }
        const int pc = 256 * u.pn + 32 * wc + 8 * fq;
#pragma unroll
        for (int ai = 0; ai < 2; ++ai) {
            const int grp = 4 * u.pm + 2 * ai + wr;
            if (fr < 2) { float* hb = HB + ((size_t)grp * 4 + fr) * NUP + pc;
#pragma unroll
                for (int bj = 0; bj < 2; ++bj)
#pragma unroll
                    for (int n = 0; n < 2; ++n) *(f32x4*)(hb + 128 * bj + 4 * n) = acc[ai][bj][0][n]; }
            if (fr >= 14) { float* hb = HB + ((size_t)grp * 4 + 2 + (fr - 14)) * NUP + pc;
#pragma unroll
                for (int bj = 0; bj < 2; ++bj)
#pragma unroll
                    for (int n = 0; n < 2; ++n) *(f32x4*)(hb + 128 * bj + 4 * n) = acc[ai][bj][3][n]; }
        }
    }
};
__device__ __forceinline__ void ph_upconv_fast(const Params& P, int l, LAS unsigned char* lds, int nrows) {
    pg8::Gemm g{(const bf16_t*)(P.ws + WS_H), wt_up(P, l), nrows, NUP, D};
    pg8::StaticOrder S; S.init(nrows, NUP, (int)gridDim.x, (int)blockIdx.x);
    EpiUpConv E{(bf16_t*)(P.ws + WS_ACT), (float*)(P.ws + WS_HB), P.in[23] + (size_t)l * 3 * NUP, P.in[24] + (size_t)l * NUP, (const float*)(P.ws + WS_STATS), (const float*)(P.ws + WS_BUP) + (size_t)l * 5 * NUP};
    pg8::gemm_phase<EpiUpConv, pg8::StaticOrder, PG8_ALIGN, PG8_SP2>(lds, g, S, E);
}
__device__ __forceinline__ void ph_fix(const Params& P, int l, int nrows) {
    const int gt = blockIdx.x * NTHREADS + tid_opaque(), NGT = gridDim.x * NTHREADS;
    const float* HB = (const float*)(P.ws + WS_HB); bf16_t* ACT = (bf16_t*)(P.ws + WS_ACT);
    const float* cw = P.in[23] + (size_t)l * 3 * NUP; const float* cb = P.in[24] + (size_t)l * NUP;
    const int per_row = DFF / 4, nitems = (nrows / 64) * 2 * per_row;
    for (int it = gt; it < nitems; it += NGT) {
        const int c = (it % per_row) * 4, ge = it / per_row, grp = ge >> 1, e = ge & 1;
        const int row = 64 * grp + (e ? 63 : 0);
        const int pos = row < MLAT ? (row & 4095) : ((row - MLAT) & 255), slen = row < MLAT ? SEQ : CTX;
        const int pa = 256 * (c >> 7) + (c & 127);
        const float* ctr = HB + ((size_t)grp * 4 + (e ? 3 : 0)) * NUP + pa;
        const float* upp = e ? HB + ((size_t)grp * 4 + 2) * NUP + pa : (pos > 0 ? HB + ((size_t)(grp - 1) * 4 + 3) * NUP + pa : nullptr);
        const float* dnp = e ? (pos < slen - 1 ? HB + ((size_t)(grp + 1) * 4 + 0) * NUP + pa : nullptr) : HB + ((size_t)grp * 4 + 1) * NUP + pa;
        f32x4 av = *(const f32x4*)(cb + c), gv = *(const f32x4*)(cb + DFF + c);
        av = av + *(const f32x4*)(cw + NUP + c) * *(const f32x4*)ctr; gv = gv + *(const f32x4*)(cw + NUP + DFF + c) * *(const f32x4*)(ctr + 128);
        if (upp) { av = av + *(const f32x4*)(cw + c) * *(const f32x4*)upp; gv = gv + *(const f32x4*)(cw + DFF + c) * *(const f32x4*)(upp + 128); }
        if (dnp) { av = av + *(const f32x4*)(cw + 2 * NUP + c) * *(const f32x4*)dnp; gv = gv + *(const f32x4*)(cw + 2 * NUP + DFF + c) * *(const f32x4*)(dnp + 128); }
        u32x2 o; o.x = pk2(av.x * silu_f(gv.x), av.y * silu_f(gv.y)); o.y = pk2(av.z * silu_f(gv.z), av.w * silu_f(gv.w));
        *(u32x2*)(ACT + (size_t)row * DFF + c) = o;
    }
}

template <int L> __device__ __forceinline__ void ph_qkv_fast(const Params& P, LAS unsigned char* lds) {
    const LayerW lw = layer_w(P, L);
    pg8::Gemm g{(const bf16_t*)(P.ws + WS_H), wt_qkv(P, L), MTOT, nqkv_of(L), D};
    pg8::StaticOrder S; S.init(MTOT, nqkv_of(L), (int)gridDim.x, (int)blockIdx.x);
    EpiQKV<L> E{(bf16_t*)(P.ws + WS_Q), (bf16_t*)(P.ws + WS_K), (bf16_t*)(P.ws + WS_V), lw.gq, lw.gk, (const float*)(P.ws + WS_ROPE), (const float*)(P.ws + WS_STATS), (const float*)(P.ws + WS_BQKV) + (size_t)L * 5 * 3072};
    pg8::gemm_phase<EpiQKV<L>, pg8::StaticOrder, PG8_ALIGN, PG8_SP2>(lds, g, S, E);
}
__device__ __forceinline__ void ph_resid_fast(const Params& P, int l, LAS unsigned char* lds, const bf16_t* A, int K, const bf16_t* W, int gate_off, int nrows, const float* gn, const float* scn) {
    pg8::Gemm g{A, W, nrows, D, K};
    pg8::StaticOrder S; S.init(nrows, D, (int)gridDim.x, (int)blockIdx.x);
    EpiResid E{P.out, (float*)(P.ws + WS_CTXRES), mod_ptr(P, l, 0) + gate_off, (bf16_t*)(P.ws + WS_H), (float*)(P.ws + WS_STATS), gn, scn};
    pg8::gemm_phase<EpiResid, pg8::StaticOrder, PG8_ALIGN, PG8_SP2>(lds, g, S, E);
}
__device__ __forceinline__ void ph_up_fast(const Params& P, int l, LAS unsigned char* lds, int r0, int nrows) {
    pg8::Gemm g{(const bf16_t*)(P.ws + WS_H) + (size_t)r0 * D, wt_up(P, l), nrows, NUP, D};
    pg8::StaticOrder S; S.init(nrows, NUP, (int)gridDim.x, (int)blockIdx.x);
    EpiStore E{(bf16_t*)(P.ws + WS_U), NUP};
    pg8::gemm_phase<EpiStore, pg8::StaticOrder, PG8_ALIGN, PG8_SP2>(lds, g, S, E);
}

namespace att {
using s16x4 = __attribute__((ext_vector_type(4))) short;
using f32x16 = __attribute__((ext_vector_type(16))) float;
constexpr int NW = 8, QBLK = 32, QB = QBLK * NW, KVBLK = 64;
constexpr int NSLOT = 3, SLOTB = 8192;
constexpr int LDS_K = 0, LDS_V = NSLOT * SLOTB, LDS_WS = 2 * NSLOT * SLOTB, LDS_OST = LDS_WS + NW * 64 * 4, LDS_BIAS = LDS_OST + NW * 4096, LDS_BYTES = LDS_BIAS + 2048;
#define SBAR() __builtin_amdgcn_sched_barrier(0)
__device__ __forceinline__ int crow(int r, int hi) { return (r & 3) + 8 * (r >> 2) + 4 * hi; }
__device__ __forceinline__ void glds16(const void* gsrc, unsigned lds_dst) { unsigned keep;
    asm volatile("s_mov_b32 %0, m0\n\ts_mov_b32 m0, %2\n\ts_nop 0\n\tglobal_load_lds_dwordx4 %1, off\n\ts_mov_b32 m0, %0" : "=&s"(keep) : "v"(gsrc), "s"(lds_dst) : "memory"); }
__device__ __forceinline__ float max3f(float a, float b, float c) { float r; asm("v_max3_f32 %0, %1, %2, %3" : "=v"(r) : "v"(a), "v"(b), "v"(c)); return r; }
__device__ __forceinline__ float max2f(float a, float b) { float r; asm("v_max_f32_e32 %0, %1, %2" : "=v"(r) : "v"(a), "v"(b)); return r; }
__device__ __forceinline__ float fadd_s(float a, float b) { float r; asm("v_add_f32_e32 %0, %1, %2" : "=v"(r) : "v"(a), "v"(b)); return r; }
__device__ __forceinline__ float fsub_s(float a, float b) { float r; asm("v_sub_f32_e32 %0, %1, %2" : "=v"(r) : "v"(a), "v"(b)); return r; }
typedef float f32x2_t __attribute__((ext_vector_type(2))); typedef __bf16 bf16x2_t __attribute__((ext_vector_type(2)));
__device__ __forceinline__ unsigned cvtpk_s(float lo, float hi) { f32x2_t v = {lo, hi}; bf16x2_t b = __builtin_convertvector(v, bf16x2_t); return __builtin_bit_cast(unsigned, b); }
#define WAIT_BAR(N) asm volatile("s_waitcnt vmcnt(" #N ") lgkmcnt(0)\n\ts_barrier" ::: "memory")

__device__ __forceinline__ void qkt(f32x16& p0, f32x16& p1, const char* Kslot, const bf16x8* qr, const f32x16& negm, int r32, int hi) {
    const char* kb = Kslot + hi * 1024 + r32 * 16;
#pragma unroll
    for (int d0 = 0; d0 < 4; ++d0) {
        const bf16x8 b0 = *reinterpret_cast<const bf16x8*>(kb + d0 * 2048);
        const bf16x8 b1 = *reinterpret_cast<const bf16x8*>(kb + d0 * 2048 + 512);
        if (d0 == 0) { p0 = __builtin_amdgcn_mfma_f32_32x32x16_bf16(b0, qr[0], negm, 0, 0, 0); p1 = __builtin_amdgcn_mfma_f32_32x32x16_bf16(b1, qr[0], negm, 0, 0, 0); }
        else { p0 = __builtin_amdgcn_mfma_f32_32x32x16_bf16(b0, qr[d0], p0, 0, 0, 0); p1 = __builtin_amdgcn_mfma_f32_32x32x16_bf16(b1, qr[d0], p1, 0, 0, 0); } }
}
typedef __attribute__((address_space(3))) const char* lds_cptr;
typedef short v4i16_t __attribute__((ext_vector_type(4)));
__device__ __forceinline__ void kload8(bf16x8* kf, lds_cptr kp) {
    kf[0] = *(const __attribute__((address_space(3))) bf16x8*)(kp);        kf[1] = *(const __attribute__((address_space(3))) bf16x8*)(kp + 512);
    kf[2] = *(const __attribute__((address_space(3))) bf16x8*)(kp + 2048); kf[3] = *(const __attribute__((address_space(3))) bf16x8*)(kp + 2560);
    kf[4] = *(const __attribute__((address_space(3))) bf16x8*)(kp + 4096); kf[5] = *(const __attribute__((address_space(3))) bf16x8*)(kp + 4608);
    kf[6] = *(const __attribute__((address_space(3))) bf16x8*)(kp + 6144); kf[7] = *(const __attribute__((address_space(3))) bf16x8*)(kp + 6656);
}
__device__ __forceinline__ void kload2(bf16x8* kf, lds_cptr kp, int j) { kf[2 * j] = *(const __attribute__((address_space(3))) bf16x8*)(kp + j * 2048); kf[2 * j + 1] = *(const __attribute__((address_space(3))) bf16x8*)(kp + j * 2048 + 512); }
__device__ __forceinline__ s16x4 vtr(lds_cptr p) { return __builtin_bit_cast(s16x4, __builtin_amdgcn_ds_read_tr16_b64_v4i16((__attribute__((address_space(3))) v4i16_t*)p)); }
__device__ __forceinline__ float rowmax(const f32x16& p0, const f32x16& p1) {
    float a = max3f(p0[0], p0[1], p1[0]), b = max3f(p0[2], p0[3], p1[1]); a = max3f(a, p1[2], p1[3]);
#pragma unroll
    for (int r = 4; r < 16; r += 4) { a = max3f(a, p0[r], p0[r + 1]); b = max3f(b, p0[r + 2], p0[r + 3]); a = max3f(a, p1[r], p1[r + 1]); b = max3f(b, p1[r + 2], p1[r + 3]); }
    const float m = max2f(a, b);
    auto rr = __builtin_amdgcn_permlane32_swap(__float_as_uint(m), __float_as_uint(m), false, false);
    return max2f(__uint_as_float(rr[0]), __uint_as_float(rr[1]));
}
__device__ __forceinline__ void pv(f32x16* o, int vb, bf16x8 pa0, bf16x8 pa1, bf16x8 pa2, bf16x8 pa3) {
#pragma unroll
    for (int d0 = 0; d0 < 2; ++d0) { s16x4 lo[4], hi[4];
#pragma unroll
        for (int ks = 0; ks < 4; ++ks) {
            asm volatile("ds_read_b64_tr_b16 %0,%1 offset:%c2" : "=&v"(lo[ks]) : "v"(vb), "i"(d0 * 4096 + ks * 1024) : "memory");
            asm volatile("ds_read_b64_tr_b16 %0,%1 offset:%c2" : "=&v"(hi[ks]) : "v"(vb), "i"(d0 * 4096 + ks * 1024 + 512) : "memory"); }
        asm volatile("s_waitcnt lgkmcnt(0)" ::: "memory"); SBAR();
#define PK(k) (bf16x8){lo[k][0], lo[k][1], lo[k][2], lo[k][3], hi[k][0], hi[k][1], hi[k][2], hi[k][3]}
        o[d0] = __builtin_amdgcn_mfma_f32_32x32x16_bf16(pa0, PK(0), o[d0], 0, 0, 0);
        o[d0] = __builtin_amdgcn_mfma_f32_32x32x16_bf16(pa1, PK(1), o[d0], 0, 0, 0);
        o[d0] = __builtin_amdgcn_mfma_f32_32x32x16_bf16(pa2, PK(2), o[d0], 0, 0, 0);
        o[d0] = __builtin_amdgcn_mfma_f32_32x32x16_bf16(pa3, PK(3), o[d0], 0, 0, 0);
#undef PK
    }
}

struct Unit {
    int qrow0;
    int kvrow0;
    int h, kvh;
    int T0, NL;
    int tq0;
    int has_sink; float sink_l2;
};
struct MaskLane { int swa_base; int rq, rs; int c, cs; };

template <int MODE> __device__ __forceinline__ void amask(f32x16& p0, f32x16& p1, int t, const Unit& u, const MaskLane& ml, int hi, lds_cptr btab) {
    if (MODE == 0) return;
    if (t < 4) return;
    const float NEG = -INFINITY;
    if (MODE == 1) {
        const int d0 = ml.swa_base + 64 * (t - 4);
#pragma unroll
        for (int r = 0; r < 16; ++r) { const int d = d0 + (r & 3) + 8 * (r >> 2); if ((unsigned)d > 256u) p0[r] = NEG; if ((unsigned)(d + 32) > 256u) p1[r] = NEG; }
    } else {
        const int kr = u.T0 + t - 4;
        if (kr < ml.rs || kr >= ml.rs + 8) {
#pragma unroll
            for (int r = 0; r < 16; ++r) { p0[r] = NEG; p1[r] = NEG; }
        } else {
            const __attribute__((address_space(3))) float* brow = (const __attribute__((address_space(3))) float*)btab + (kr - ml.rq + 7) * 31 + (15 - ml.c + 4 * hi);
            const int k0 = 4 * hi - ml.cs;
#pragma unroll
            for (int r = 0; r < 16; ++r) { const int kk = (r & 3) + 8 * (r >> 2);
                const float b0 = brow[kk], b1 = brow[kk + 32];
                p0[r] = ((unsigned)(k0 + kk) < 16u) ? p0[r] + b0 : NEG;
                p1[r] = ((unsigned)(k0 + kk + 32) < 16u) ? p1[r] + b1 : NEG; }
        }
    }
}

template <int MODE, int KVP, int THRL>
__device__ __forceinline__ void attn_unit(const Unit& u, const bf16_t* Q, const bf16_t* __restrict__ K, const bf16_t* __restrict__ V, bf16_t* O, const float* rpb_h, char* shm) {
    const int tid = tid_opaque(), lane = tid & 63, r32 = lane & 31, hi = lane >> 5; const int wid = __builtin_amdgcn_readfirstlane(tid >> 6);
    const bf16_t* Qw = Q + (size_t)(u.qrow0 + wid * QBLK) * D + u.h * 64;
    const bf16_t* Kh = K + (size_t)u.kvrow0 * KVP + u.kvh * 64; const bf16_t* Vh = V + (size_t)u.kvrow0 * KVP + u.kvh * 64;
    const unsigned lds0 = (unsigned)(uintptr_t)shm;
    float* wsf = (float*)(shm + LDS_WS) + wid * 64;
    const bf16_t* ksrc = Kh + (long)lane * KVP + wid * 8;
    const bf16_t* vsrc = Vh + (long)(16 * (wid & 3) + (lane >> 2)) * KVP + (wid >> 2) * 32 + (lane & 3) * 8;
    const unsigned kdst = lds0 + LDS_K + wid * 1024, vdst = lds0 + LDS_V + wid * 1024;
    const int T0 = u.T0;
#define TPOS(t) ((long)(((t) < 4) ? (SEQ + 64 * (t)) : 64 * (T0 + (t) - 4)) * KVP)
#define DMA_K(t, slot) glds16(ksrc + TPOS(t), (unsigned)__builtin_amdgcn_readfirstlane(kdst + (slot)))
#define DMA_V(t, slot) glds16(vsrc + TPOS(t), (unsigned)__builtin_amdgcn_readfirstlane(vdst + (slot)))
    const int vb0 = (int)(lds0 + LDS_V) + ((lane >> 4) & 1) * 32 + (lane & 3) * 8 + (4 * hi + ((lane & 15) >> 2)) * 64;
    const char* Kbase = shm + LDS_K; bf16x8 kf[8];
    const lds_cptr shm3 = (lds_cptr)shm; const lds_cptr kp0 = shm3 + LDS_K + hi * 1024 + r32 * 16; const lds_cptr vp0 = shm3 + LDS_V + ((lane >> 4) & 1) * 32 + (lane & 3) * 8 + (4 * hi + ((lane & 15) >> 2)) * 64;
    const lds_cptr btab = shm3 + LDS_BIAS;
    const int NT = 4 + u.NL;
    DMA_K(0, 0); DMA_V(0, 0); DMA_K(1, SLOTB);
    MaskLane ml; ml.swa_base = 0; ml.rq = 0; ml.rs = 0; ml.c = 0; ml.cs = 0;
    if (MODE == 1) ml.swa_base = 64 * T0 - (u.tq0 + wid * QBLK + r32) + 128 + 4 * hi;
    if (MODE == 2) { ml.rq = (u.tq0 >> 6) + (wid >> 1); int rs = ml.rq - 4; ml.rs = rs < 0 ? 0 : (rs > 56 ? 56 : rs); ml.c = 32 * (wid & 1) + r32; int cs = ml.c - 8; ml.cs = cs < 0 ? 0 : (cs > 48 ? 48 : cs);
        if (tid < 15 * 31) ((float*)(shm + LDS_BIAS))[tid] = rpb_h[tid] * LOG2E; }
    bf16x8 qr[4];
#pragma unroll
    for (int d0 = 0; d0 < 4; ++d0) qr[d0] = *reinterpret_cast<const bf16x8*>(&Qw[(long)r32 * D + d0 * 16 + hi * 8]);
    float mhat = 0.f, l_reg = 0.f; f32x16 o[2]; o[0] = f32x16{}; o[1] = f32x16{}; f32x16 negm = f32x16{}; asm volatile("" : "+v"(negm));
#define CMASK(P0, P1, t) amask<MODE>(P0, P1, (t), u, ml, hi, btab)
    bool resc = false;
#define START(P0, P1) do { const float rm = rowmax(P0, P1); resc = false; \
    { const float dl = rm; mhat = fadd_s(mhat, dl); \
      _Pragma("unroll") for (int r = 0; r < 16; ++r) { P0[r] = fsub_s(P0[r], dl); P1[r] = fsub_s(P1[r], dl); } \
      _Pragma("unroll") for (int r = 0; r < 16; ++r) negm[r] = -mhat; asm volatile("" : "+v"(negm)); } \
    _Pragma("unroll") for (int r = 0; r < 16; ++r) P0[r] = __builtin_amdgcn_exp2f(P0[r]); } while (0)
#define RESC() do { if (resc) { asm volatile("s_waitcnt lgkmcnt(0)" ::: "memory"); \
      _Pragma("unroll") for (int d_ = 0; d_ < 2; ++d_) _Pragma("unroll") for (int r = 0; r < 16; ++r) o[d_][r] *= wsf[crow(r, hi)]; } } while (0)
    f32x16 pA0, pA1, pB0, pB1;
    int sl_prev = 0, sl_cur = 0, sl_next = SLOTB;
#define ROT() do { sl_prev = sl_cur; sl_cur = sl_next; sl_next = (sl_next == (NSLOT - 1) * SLOTB) ? 0 : sl_next + SLOTB; } while (0)
    DMA_K(2, 2 * SLOTB);
    WAIT_BAR(3);
    qkt(pA0, pA1, Kbase, qr, negm, r32, hi); asm volatile("s_nop 15\n\ts_nop 7" : "+v"(pA0), "+v"(pA1));
    START(pA0, pA1);
    _Pragma("unroll") for (int r = 0; r < 16; ++r) pA1[r] = __builtin_amdgcn_exp2f(pA1[r]);
    WAIT_BAR(0);
    DMA_K(3, 0); DMA_V(1, SLOTB);
    ROT();
    kload8(kf, kp0 + sl_cur);
    WAIT_BAR(2);
    s16x4 vlo[8], vhi[8]; u32x4 pw0, pw1, pw2, pw3;
#define PKW(P, B) cvtpk_s(P[B], P[B + 1])
#define PAF(k) __builtin_bit_cast(bf16x8, pw##k)
#define VFR(i) (bf16x8){vlo[i][0], vlo[i][1], vlo[i][2], vlo[i][3], vhi[i][0], vhi[i][1], vhi[i][2], vhi[i][3]}
#define PIN(x) asm volatile("" : "+v"(x))
#define MX3(a, b, c) __builtin_fmaxf(__builtin_fmaxf((a), (b)), (c))
#define GAPA(MF, A0, A1, A2, A3, W0, W1, PW) do { MF; sacc += A0; sacc += A1; sacc += A2; sacc += A3; PIN(sacc); W0; W1; PIN(PW); SBAR(); } while (0)
#define EX(v) __builtin_amdgcn_exp2f(v)
#define GAPB(MF, X, B) do { MF; X[B] = EX(X[B]); X[B + 1] = EX(X[B + 1]); X[B + 2] = EX(X[B + 2]); X[B + 3] = EX(X[B + 3]); PIN(X); SBAR(); } while (0)
#define VRD(i) do { vlo[i] = vtr(vp_ + (((i) >> 2) * 4096 + ((i) & 3) * 1024)); vhi[i] = vtr(vp_ + (((i) >> 2) * 4096 + ((i) & 3) * 1024 + 512)); } while (0)
#define KRD(G, j) do { if (G) { kload2(kf, kp0 + sl_next, j); SBAR(); } } while (0)
#define STEP(C0, C1, P0, P1, t, GK, GV, GL) do { SBAR(); \
    const lds_cptr vp_ = vp0 + sl_prev; \
    VRD(0); SBAR(); float sacc = (P0[0] + P0[1]); \
    GAPA(C0 = __builtin_amdgcn_mfma_f32_32x32x16_bf16(kf[0], qr[0], negm, 0, 0, 0), P0[2], P0[3], P0[4], P0[5],     pw0[0] = PKW(P0, 0), pw0[1] = PKW(P0, 2), pw0); \
    VRD(4); SBAR(); GAPA(C1 = __builtin_amdgcn_mfma_f32_32x32x16_bf16(kf[1], qr[0], negm, 0, 0, 0), P0[6], P0[7], P0[8], P0[9],     pw0[2] = PKW(P0, 4), pw0[3] = PKW(P0, 6), pw0); \
    VRD(1); SBAR(); GAPA(C0 = __builtin_amdgcn_mfma_f32_32x32x16_bf16(kf[2], qr[1], C0, 0, 0, 0),   P0[10], P0[11], P0[12], P0[13], pw1[0] = PKW(P0, 8), pw1[1] = PKW(P0, 10), pw1); \
    VRD(5); SBAR(); GAPA(C1 = __builtin_amdgcn_mfma_f32_32x32x16_bf16(kf[3], qr[1], C1, 0, 0, 0),   P0[14], P0[15], P1[0], P1[1],   pw1[2] = PKW(P0, 12), pw1[3] = PKW(P0, 14), pw1); \
    VRD(2); SBAR(); GAPA(C0 = __builtin_amdgcn_mfma_f32_32x32x16_bf16(kf[4], qr[2], C0, 0, 0, 0),   P1[2], P1[3], P1[4], P1[5],     pw2[0] = PKW(P1, 0), pw2[1] = PKW(P1, 2), pw2); \
    VRD(6); SBAR(); GAPA(C1 = __builtin_amdgcn_mfma_f32_32x32x16_bf16(kf[5], qr[2], C1, 0, 0, 0),   P1[6], P1[7], P1[8], P1[9],     pw2[2] = PKW(P1, 4), pw2[3] = PKW(P1, 6), pw2); \
    VRD(3); SBAR(); GAPA(C0 = __builtin_amdgcn_mfma_f32_32x32x16_bf16(kf[6], qr[3], C0, 0, 0, 0),   P1[10], P1[11], P1[12], P1[13], pw3[0] = PKW(P1, 8), pw3[1] = PKW(P1, 10), pw3); \
    VRD(7); SBAR(); GAPA(C1 = __builtin_amdgcn_mfma_f32_32x32x16_bf16(kf[7], qr[3], C1, 0, 0, 0),   P1[14], P1[15], 0.f, 0.f,       pw3[2] = PKW(P1, 12), pw3[3] = PKW(P1, 14), pw3); \
    l_reg += sacc; \
    if (GK) { DMA_K((t) + 3, sl_cur); } if (GV) { DMA_V((t) + 1, sl_next); } \
    CMASK(C0, C1, t); \
    { float a = MX3(C0[0], C0[1], C1[0]), b = MX3(C0[2], C0[3], C1[1]); a = MX3(a, C1[2], C1[3]); \
      _Pragma("unroll") for (int r = 4; r < 16; r += 4) { a = MX3(a, C0[r], C0[r + 1]); b = MX3(b, C0[r + 2], C0[r + 3]); a = MX3(a, C1[r], C1[r + 1]); b = MX3(b, C1[r + 2], C1[r + 3]); } \
      float rm = __builtin_fmaxf(a, b); { auto rr = __builtin_amdgcn_permlane32_swap(__float_as_uint(rm), __float_as_uint(rm), false, false); rm = __builtin_fmaxf(__uint_as_float(rr[0]), __uint_as_float(rr[1])); } \
      resc = false; \
      if (__builtin_expect(__any(rm > (float)THRL), 0)) { const float dl = __builtin_fmaxf(rm, 0.f); mhat += dl; \
        _Pragma("unroll") for (int r = 0; r < 16; ++r) { C0[r] -= dl; C1[r] -= dl; } \
        _Pragma("unroll") for (int r = 0; r < 16; ++r) negm[r] = -mhat; asm volatile("" : "+v"(negm)); \
        const float f = __builtin_amdgcn_exp2f(-dl); l_reg *= f; if (hi == 0) wsf[r32] = f; resc = true; } } \
    SBAR(); \
    GAPB(o[0] = __builtin_amdgcn_mfma_f32_32x32x16_bf16(PAF(0), VFR(0), o[0], 0, 0, 0), C0, 0); \
    GAPB(o[1] = __builtin_amdgcn_mfma_f32_32x32x16_bf16(PAF(0), VFR(4), o[1], 0, 0, 0), C0, 4); \
    KRD(GL, 0); GAPB(o[0] = __builtin_amdgcn_mfma_f32_32x32x16_bf16(PAF(1), VFR(1), o[0], 0, 0, 0), C0, 8); \
    KRD(GL, 1); GAPB(o[1] = __builtin_amdgcn_mfma_f32_32x32x16_bf16(PAF(1), VFR(5), o[1], 0, 0, 0), C0, 12); \
    KRD(GL, 2); GAPB(o[0] = __builtin_amdgcn_mfma_f32_32x32x16_bf16(PAF(2), VFR(2), o[0], 0, 0, 0), C1, 0); \
    KRD(GL, 3); GAPB(o[1] = __builtin_amdgcn_mfma_f32_32x32x16_bf16(PAF(2), VFR(6), o[1], 0, 0, 0), C1, 4); \
    GAPB(o[0] = __builtin_amdgcn_mfma_f32_32x32x16_bf16(PAF(3), VFR(3), o[0], 0, 0, 0), C1, 8); \
    GAPB(o[1] = __builtin_amdgcn_mfma_f32_32x32x16_bf16(PAF(3), VFR(7), o[1], 0, 0, 0), C1, 12); \
    } while (0)
    int t = 1;
    for (; t + 5 < NT; t += 2) {
        STEP(pB0, pB1, pA0, pA1, t, true, true, true);     WAIT_BAR(2); RESC(); ROT();
        STEP(pA0, pA1, pB0, pB1, t + 1, true, true, true); WAIT_BAR(2); RESC(); ROT();
    }
#define ENDW(tt) do { if ((tt) + 3 < NT) { WAIT_BAR(2); } else if ((tt) + 2 < NT) { WAIT_BAR(1); } else { WAIT_BAR(0); } } while (0)
    for (; t + 1 < NT; t += 2) {
        STEP(pB0, pB1, pA0, pA1, t, (t + 3 < NT), (t + 1 < NT), (t + 1 < NT));         ENDW(t);     RESC(); ROT();
        STEP(pA0, pA1, pB0, pB1, t + 1, (t + 4 < NT), (t + 2 < NT), (t + 2 < NT));     ENDW(t + 1); RESC(); ROT();
    }
    STEP(pB0, pB1, pA0, pA1, NT - 1, false, false, false); RESC();
    { float sacc = pB0[0] + pB0[1]; _Pragma("unroll") for (int r = 2; r < 16; ++r) sacc += pB0[r]; _Pragma("unroll") for (int r = 0; r < 16; ++r) sacc += pB1[r]; l_reg += sacc;
      pw0 = (u32x4){PKW(pB0, 0), PKW(pB0, 2), PKW(pB0, 4), PKW(pB0, 6)}; pw1 = (u32x4){PKW(pB0, 8), PKW(pB0, 10), PKW(pB0, 12), PKW(pB0, 14)}; pw2 = (u32x4){PKW(pB1, 0), PKW(pB1, 2), PKW(pB1, 4), PKW(pB1, 6)}; pw3 = (u32x4){PKW(pB1, 8), PKW(pB1, 10), PKW(pB1, 12), PKW(pB1, 14)};
      SBAR(); pv(o, vb0 + sl_cur, PAF(0), PAF(1), PAF(2), PAF(3)); }
#undef PKW
#undef PAF
#undef VFR
#undef PIN
#undef MX3
#undef GAPA
#undef GAPB
#undef EX
#undef VRD
#undef KRD
#undef STEP
#undef ENDW
    { auto rr = __builtin_amdgcn_permlane32_swap(__float_as_uint(l_reg), __float_as_uint(l_reg), false, false); l_reg = __uint_as_float(rr[0]) + __uint_as_float(rr[1]); }
    if (u.has_sink) l_reg += __builtin_amdgcn_exp2f(u.sink_l2 - mhat);
    if (hi == 0) wsf[32 + r32] = l_reg; asm volatile("s_waitcnt lgkmcnt(0)" ::: "memory");
    float rli[16];
#pragma unroll
    for (int r = 0; r < 16; ++r) rli[r] = __builtin_amdgcn_rcpf(wsf[32 + crow(r, hi)]);
    bf16_t* Ow = O + (size_t)(u.qrow0 + wid * QBLK) * D + u.h * 64;
    { bf16_t* stg = (bf16_t*)(shm + LDS_OST) + wid * 2048;
#pragma unroll
      for (int r = 0; r < 16; ++r) { const int orow = crow(r, hi);
#pragma unroll
          for (int d0 = 0; d0 < 2; ++d0) stg[orow * 64 + d0 * 32 + r32] = (bf16_t)f2bf(o[d0][r] * rli[r]); }
      asm volatile("s_waitcnt lgkmcnt(0)" ::: "memory");
#pragma unroll
      for (int i = 0; i < 4; ++i) { const int row = i * 8 + (lane >> 3), ch = lane & 7; const u32x4 v = *(const u32x4*)(stg + row * 64 + ch * 8); *(u32x4*)(Ow + (long)row * D + ch * 8) = v; } }
    asm volatile("s_waitcnt lgkmcnt(0)\n\ts_barrier" ::: "memory");
#undef DMA_K
#undef DMA_V
#undef TPOS
#undef CMASK
#undef START
#undef RESC
#undef ROT
}

__device__ __forceinline__ void qkt_lds(f32x16& p0, f32x16& p1, lds_cptr kb, const bf16x8* qr) {
    const f32x16 z = f32x16{};
#pragma unroll
    for (int d0 = 0; d0 < 4; ++d0) {
        const bf16x8 b0 = *(const __attribute__((address_space(3))) bf16x8*)(kb + d0 * 2048);
        const bf16x8 b1 = *(const __attribute__((address_space(3))) bf16x8*)(kb + d0 * 2048 + 512);
        if (d0 == 0) { p0 = __builtin_amdgcn_mfma_f32_32x32x16_bf16(b0, qr[0], z, 0, 0, 0); p1 = __builtin_amdgcn_mfma_f32_32x32x16_bf16(b1, qr[0], z, 0, 0, 0); }
        else { p0 = __builtin_amdgcn_mfma_f32_32x32x16_bf16(b0, qr[d0], p0, 0, 0, 0); p1 = __builtin_amdgcn_mfma_f32_32x32x16_bf16(b1, qr[d0], p1, 0, 0, 0); } }
}
template <int MODE, int KVP>
__device__ __forceinline__ void attn_unit_simple(const Unit& u, const bf16_t* Q, const bf16_t* __restrict__ K, const bf16_t* __restrict__ V, bf16_t* O, const float* rpb_h, char* shm) {
    const int tid = tid_opaque(), lane = tid & 63, r32 = lane & 31, hi = lane >> 5; const int wid = __builtin_amdgcn_readfirstlane(tid >> 6);
    const bf16_t* Qw = Q + (size_t)(u.qrow0 + wid * QBLK) * D + u.h * 64;
    const bf16_t* Kh = K + (size_t)u.kvrow0 * KVP + u.kvh * 64; const bf16_t* Vh = V + (size_t)u.kvrow0 * KVP + u.kvh * 64;
    const unsigned lds0 = (unsigned)(uintptr_t)shm;
    float* wsf = (float*)(shm + LDS_WS) + wid * 64;
    const bf16_t* ksrc = Kh + (long)lane * KVP + wid * 8;
    const bf16_t* vsrc = Vh + (long)(16 * (wid & 3) + (lane >> 2)) * KVP + (wid >> 2) * 32 + (lane & 3) * 8;
    const unsigned kdst = lds0 + LDS_K + wid * 1024, vdst = lds0 + LDS_V + wid * 1024;
    const int T0 = u.T0;
#define TPOS(t) ((long)(((t) < 4) ? (SEQ + 64 * (t)) : 64 * (T0 + (t) - 4)) * KVP)
#define DMA_K(t, slot) glds16(ksrc + TPOS(t), (unsigned)__builtin_amdgcn_readfirstlane(kdst + (slot)))
#define DMA_V(t, slot) glds16(vsrc + TPOS(t), (unsigned)__builtin_amdgcn_readfirstlane(vdst + (slot)))
    const int vb0 = (int)(lds0 + LDS_V) + ((lane >> 4) & 1) * 32 + (lane & 3) * 8 + (4 * hi + ((lane & 15) >> 2)) * 64;
    const lds_cptr shm3 = (lds_cptr)shm; const lds_cptr kp0 = shm3 + LDS_K + hi * 1024 + r32 * 16;
    const lds_cptr btab = shm3 + LDS_BIAS;
    const int NT = 4 + u.NL;
    DMA_K(0, 0); DMA_V(0, 0);
    MaskLane ml; ml.swa_base = 0; ml.rq = 0; ml.rs = 0; ml.c = 0; ml.cs = 0;
    if (MODE == 1) ml.swa_base = 64 * T0 - (u.tq0 + wid * QBLK + r32) + 128 + 4 * hi;
    if (MODE == 2) { ml.rq = (u.tq0 >> 6) + (wid >> 1); int rs = ml.rq - 4; ml.rs = rs < 0 ? 0 : (rs > 56 ? 56 : rs); ml.c = 32 * (wid & 1) + r32; int cs = ml.c - 8; ml.cs = cs < 0 ? 0 : (cs > 48 ? 48 : cs);
        if (tid < 15 * 31) ((float*)(shm + LDS_BIAS))[tid] = rpb_h[tid] * LOG2E; }
    bf16x8 qr[4];
#pragma unroll
    for (int d0 = 0; d0 < 4; ++d0) qr[d0] = *reinterpret_cast<const bf16x8*>(&Qw[(long)r32 * D + d0 * 16 + hi * 8]);
    float mhat = -INFINITY, l_reg = 0.f; f32x16 o[2]; o[0] = f32x16{}; o[1] = f32x16{};
    int slot = 0;
    for (int t = 0; t < NT; ++t) {
        asm volatile("s_waitcnt vmcnt(0) lgkmcnt(0)\n\ts_barrier" ::: "memory");
        if (t + 1 < NT) { DMA_K(t + 1, slot ^ SLOTB); DMA_V(t + 1, slot ^ SLOTB); }
        f32x16 p0, p1;
        qkt_lds(p0, p1, kp0 + slot, qr);
        asm volatile("s_nop 15\n\ts_nop 7" : "+v"(p0), "+v"(p1));
        amask<MODE>(p0, p1, t, u, ml, hi, btab);
        float a = __builtin_fmaxf(p0[0], p1[0]);
#pragma unroll
        for (int r = 1; r < 16; ++r) a = __builtin_fmaxf(a, __builtin_fmaxf(p0[r], p1[r]));
        { auto rr = __builtin_amdgcn_permlane32_swap(__float_as_uint(a), __float_as_uint(a), false, false); a = __builtin_fmaxf(__uint_as_float(rr[0]), __uint_as_float(rr[1])); }
        const float mnew = __builtin_fmaxf(mhat, a);
        const float alpha = __builtin_amdgcn_exp2f(mhat - mnew);
        mhat = mnew;
        float sacc = 0.f;
#pragma unroll
        for (int r = 0; r < 16; ++r) { p0[r] = __builtin_amdgcn_exp2f(p0[r] - mnew); p1[r] = __builtin_amdgcn_exp2f(p1[r] - mnew); sacc += p0[r] + p1[r]; }
        l_reg = l_reg * alpha + sacc;
        if (__any(alpha != 1.0f)) {
            if (hi == 0) wsf[r32] = alpha;
            asm volatile("s_waitcnt lgkmcnt(0)" ::: "memory");
#pragma unroll
            for (int r = 0; r < 16; ++r) { const float f = wsf[crow(r, hi)]; o[0][r] *= f; o[1][r] *= f; }
        }
        u32x4 pw0, pw1, pw2, pw3;
        pw0 = (u32x4){cvtpk_s(p0[0], p0[1]), cvtpk_s(p0[2], p0[3]), cvtpk_s(p0[4], p0[5]), cvtpk_s(p0[6], p0[7])};
        pw1 = (u32x4){cvtpk_s(p0[8], p0[9]), cvtpk_s(p0[10], p0[11]), cvtpk_s(p0[12], p0[13]), cvtpk_s(p0[14], p0[15])};
        pw2 = (u32x4){cvtpk_s(p1[0], p1[1]), cvtpk_s(p1[2], p1[3]), cvtpk_s(p1[4], p1[5]), cvtpk_s(p1[6], p1[7])};
        pw3 = (u32x4){cvtpk_s(p1[8], p1[9]), cvtpk_s(p1[10], p1[11]), cvtpk_s(p1[12], p1[13]), cvtpk_s(p1[14], p1[15])};
        SBAR();
        pv(o, vb0 + slot, __builtin_bit_cast(bf16x8, pw0), __builtin_bit_cast(bf16x8, pw1), __builtin_bit_cast(bf16x8, pw2), __builtin_bit_cast(bf16x8, pw3));
        slot ^= SLOTB;
    }
    { auto rr = __builtin_amdgcn_permlane32_swap(__float_as_uint(l_reg), __float_as_uint(l_reg), false, false); l_reg = __uint_as_float(rr[0]) + __uint_as_float(rr[1]); }
    if (u.has_sink) l_reg += __builtin_amdgcn_exp2f(u.sink_l2 - mhat);
    if (hi == 0) wsf[32 + r32] = l_reg; asm volatile("s_waitcnt lgkmcnt(0)" ::: "memory");
    float rli[16];
#pragma unroll
    for (int r = 0; r < 16; ++r) rli[r] = __builtin_amdgcn_rcpf(wsf[32 + crow(r, hi)]);
    bf16_t* Ow = O + (size_t)(u.qrow0 + wid * QBLK) * D + u.h * 64;
    { bf16_t* stg = (bf16_t*)(shm + LDS_OST) + wid * 2048;
#pragma unroll
      for (int r = 0; r < 16; ++r) { const int orow = crow(r, hi);
#pragma unroll
          for (int d0 = 0; d0 < 2; ++d0) stg[orow * 64 + d0 * 32 + r32] = (bf16_t)f2bf(o[d0][r] * rli[r]); }
      asm volatile("s_waitcnt lgkmcnt(0)" ::: "memory");
#pragma unroll
      for (int i = 0; i < 4; ++i) { const int row = i * 8 + (lane >> 3), ch = lane & 7; const u32x4 v = *(const u32x4*)(stg + row * 64 + ch * 8); *(u32x4*)(Ow + (long)row * D + ch * 8) = v; } }
    asm volatile("s_waitcnt lgkmcnt(0)\n\ts_barrier" ::: "memory");
#undef DMA_K
#undef DMA_V
#undef TPOS
}
#undef SBAR
#undef WAIT_BAR
}

template <int L> __device__ __forceinline__ void ph_attn_fast(const Params& P, LAS unsigned char* lds) {
    constexpr int kind = kind_of(L), kvw = kvw_of(L); constexpr bool last = (L == DEPTH - 1);
    constexpr int MODE = kind == 0 ? 2 : (kind == 1 ? 1 : 0);
    const LayerW lw = layer_w(P, L);
    const bf16_t* Qb = (const bf16_t*)(P.ws + WS_Q); const bf16_t* Kb = (const bf16_t*)(P.ws + WS_K); const bf16_t* Vb = (const bf16_t*)(P.ws + WS_V);
    bf16_t* Ob = (bf16_t*)(P.ws + WS_O);
    char* shm = (char*)lds;
    const int G = gridDim.x, bx = blockIdx.x; const int vcu = (G % 8 == 0) ? (bx % 8) * (G / 8) + bx / 8 : bx;
    for (int uix = vcu * 4; uix < 1024; uix += G * 4) {
        for (int i = 0; i < 4; ++i) {
            const int ui = uix + i, bh = ui >> 4, qb = ui & 15, b = bh >> 4, h = bh & 15;
            att::Unit u; u.qrow0 = b * SEQ + qb * 256; u.kvrow0 = b * KVROWS; u.h = h; u.kvh = kind == 0 ? h : (h >> 2); u.tq0 = qb * 256;
            u.has_sink = kind == 1 ? 1 : 0; u.sink_l2 = kind == 1 ? lw.sink[h] * LOG2E : 0.f;
            if (kind == 2) { u.T0 = 0; u.NL = 64; }
            else if (kind == 1) { const int lo = 4 * qb - 2 < 0 ? 0 : 4 * qb - 2, hi_ = 4 * qb + 6 > 64 ? 64 : 4 * qb + 6; u.T0 = lo; u.NL = hi_ - lo; }
            else { if (qb == 0) { u.T0 = 0; u.NL = 8; } else if (qb == 15) { u.T0 = 56; u.NL = 8; } else { u.T0 = 4 * qb - 4; u.NL = 12; } }
            if constexpr (MODE == 0) att::attn_unit<0, kvw, 8>(u, Qb, Kb, Vb, Ob, nullptr, shm);
            else att::attn_unit_simple<MODE, kvw>(u, Qb, Kb, Vb, Ob, kind == 0 ? lw.rpb + (size_t)h * 15 * 31 : nullptr, shm);
        }
    }
    if (!last) {
        for (int ui = vcu; ui < 64; ui += G) {
            const int b = ui >> 4, h = ui & 15;
            att::Unit u; u.qrow0 = MLAT + b * CTX; u.kvrow0 = b * KVROWS; u.h = h; u.kvh = kind == 0 ? h : (h >> 2); u.tq0 = 0; u.T0 = 0; u.NL = 0;
            u.has_sink = kind == 1 ? 1 : 0; u.sink_l2 = kind == 1 ? lw.sink[h] * LOG2E : 0.f;
            att::attn_unit<0, kvw, 8>(u, Qb, Kb, Vb, Ob, nullptr, shm);
        }
    }
}

#define XB_TMO      128
#define XB_XCNT(j)  (256  + 64 * (j))
#define XB_XSUB(j)  (1280 + 64 * (j))
#define XB_XGEN(j)  (2304 + 64 * (j))
#define XB_TOP      3328
#define XB_TOPGEN   3392
#define XCD_BAR_WORDS 3456
#define XB_SPIN_CAP (1u << 18)

__device__ __forceinline__ unsigned xb_ld(unsigned* p)              { return __hip_atomic_load(p, __ATOMIC_RELAXED, __HIP_MEMORY_SCOPE_AGENT); }
__device__ __forceinline__ unsigned xb_add(unsigned* p, unsigned v) { return __hip_atomic_fetch_add(p, v, __ATOMIC_RELAXED, __HIP_MEMORY_SCOPE_AGENT); }
__device__ __forceinline__ unsigned xb_xcc_id() { return (unsigned)__builtin_amdgcn_s_getreg((3 << 11) | 20) & 0xFu; }
#define XB_SPIN(cond, bar) do { unsigned _sp = 0; while (cond) { __builtin_amdgcn_s_sleep(1); \
    if ((++_sp & 255u) == 0u) { if (xb_ld(&(bar)[XB_TMO])) break; if (_sp > XB_SPIN_CAP) { atomicAdd(&(bar)[XB_TMO], 1u); break; } } } } while (0)

struct XcdBarrier {
    unsigned* bar; unsigned x;
    volatile LAS unsigned* st;
};

__device__ __forceinline__ XcdBarrier xcd_barrier_post(unsigned* bar, volatile LAS unsigned* st) {
    XcdBarrier b; b.bar = bar; b.x = xb_xcc_id(); b.st = st;
    if (threadIdx.x == 0) (void)xb_add(&bar[XB_XCNT(b.x)], 1u);
    return b;
}
__device__ __forceinline__ void xcd_barrier_complete(unsigned* bar, unsigned x, unsigned& nloc, unsigned& nx) {
    const unsigned G = gridDim.x * gridDim.y * gridDim.z;
    unsigned sum, cnt, mine, sp = 0u;
    for (;;) {
        sum = 0u; cnt = 0u; mine = 0u;
#pragma unroll
        for (unsigned j = 0; j < 16; ++j) { const unsigned c = xb_ld(&bar[XB_XCNT(j)]); sum += c; cnt += (c > 0u) ? 1u : 0u; mine = (j == x) ? c : mine; }
        if (sum == G) break;
        __builtin_amdgcn_s_sleep(1);
        if ((++sp & 255u) == 0u) { if (xb_ld(&bar[XB_TMO])) break; if (sp > XB_SPIN_CAP) { atomicAdd(&bar[XB_TMO], 1u); break; } }
    }
    nloc = mine > 0u ? mine : 1u; nx = cnt > 0u ? cnt : 1u;
}

__device__ __forceinline__ void xcd_barrier(const XcdBarrier& b) {
    asm volatile("s_waitcnt vmcnt(0)" ::: "memory");
    __syncthreads();
    if (threadIdx.x == 0) {
        unsigned* bar = b.bar;
        __builtin_amdgcn_s_waitcnt(0);
        unsigned nloc = b.st[0], nx = b.st[1];
        if (nloc == 0u) { xcd_barrier_complete(bar, b.x, nloc, nx); b.st[0] = nloc; b.st[1] = nx; }
        const unsigned old = xb_add(&bar[XB_XSUB(b.x)], 1u);
        const unsigned gen = old / nloc;
        if (old + 1u == (gen + 1u) * nloc) {
            __builtin_amdgcn_fence(__ATOMIC_RELEASE, "agent");
            asm volatile("s_waitcnt vmcnt(0)" ::: "memory");
            const unsigned og = xb_add(&bar[XB_TOP], 1u);
            const unsigned tg = og / nx;
            if (og + 1u == (tg + 1u) * nx) xb_add(&bar[XB_TOPGEN], 1u);
            else XB_SPIN(xb_ld(&bar[XB_TOPGEN]) == tg, bar);
            __builtin_amdgcn_fence(__ATOMIC_ACQUIRE, "agent");
            xb_add(&bar[XB_XGEN(b.x)], 1u);
            asm volatile("s_waitcnt vmcnt(0)" ::: "memory");
        } else {
            XB_SPIN(xb_ld(&bar[XB_XGEN(b.x)]) == gen, bar);
            __builtin_amdgcn_fence(__ATOMIC_ACQUIRE, "agent");
            asm volatile("s_waitcnt vmcnt(0)" ::: "memory");
        }
    }
    __syncthreads();
}

constexpr int STAGES = 6, NPHASES = 2 + DEPTH * STAGES;
constexpr int LDS_BYTES = 147456, LDS_MISC = LDS_BYTES - 64;
constexpr int CH0_ROWS = 8192;

#ifndef REP_SYNC
#define REP_SYNC 1
#endif
#ifndef REP_ATTN
#define REP_ATTN 1
#endif
#define PHASE(k, body) do { if (P.ph_lo <= (k) && (k) < P.ph_hi) { body; if ((k) + 1 < P.ph_hi) { for (int rs_ = 0; rs_ < REP_SYNC; ++rs_) { if ((k) == 0) grid.sync(); else xcd_barrier(bar); } } } } while (0)

template <int L> __device__ __forceinline__ void run_layer(const Params& P, cg::grid_group& grid, const XcdBarrier& bar, LAS unsigned char* lds, int wave, int lane) {
    constexpr bool last = (L == DEPTH - 1);
    constexpr int nrows = last ? MLAT : MTOT;
    constexpr int k0 = 2 + L * STAGES;
    constexpr int LN = last ? L : L + 1;
    PHASE(k0 + 0, ph_qkv_fast<L>(P, lds));
    PHASE(k0 + 1, { for (int ra_ = 0; ra_ < REP_ATTN; ++ra_) ph_attn_fast<L>(P, lds); });
    PHASE(k0 + 2, ph_resid_fast(P, L, lds, (const bf16_t*)(P.ws + WS_O), D, wt_o(P, L), 2048, nrows, P.in[7] + L * D, mod_ptr(P, L, 0) + 4096));
    PHASE(k0 + 3, ph_upconv_fast(P, L, lds, nrows));
    PHASE(k0 + 4, ph_fix(P, L, nrows));
    PHASE(k0 + 5, ph_resid_fast(P, L, lds, (const bf16_t*)(P.ws + WS_ACT), DFF, wt_dn(P, L), 5120, nrows, last ? nullptr : P.in[6] + LN * D, mod_ptr(P, LN, 0) + 1024));
}

__global__ void __launch_bounds__(NTHREADS, 2) fwd_kernel(Params P) {
    extern __shared__ __attribute__((aligned(16))) unsigned char lds_raw[];
    LAS unsigned char* lds = (LAS unsigned char*)lds_raw;
    cg::grid_group grid = cg::this_grid();
    const int wave = 0, lane = 0; (void)wave; (void)lane;
    volatile LAS unsigned* MISC = (volatile LAS unsigned*)(lds + LDS_MISC);
    { const int t0_ = tid_opaque(); if (t0_ < 16) MISC[t0_] = 0u; }
    __syncthreads();
    const XcdBarrier bar = xcd_barrier_post((unsigned*)(P.ws + WS_BAR), MISC + 8);
    PHASE(0, ph_prologue(P, lds));
    PHASE(1, ph_prologue_b(P));
    run_layer<0>(P, grid, bar, lds, wave, lane);
    run_layer<1>(P, grid, bar, lds, wave, lane);
    run_layer<2>(P, grid, bar, lds, wave, lane);
    run_layer<3>(P, grid, bar, lds, wave, lane);
}

extern "C" void kernel_launch(void* const* d_in, const int* in_sizes, int n_in, void* d_out, int out_size, void* d_ws, size_t ws_size, hipStream_t stream) {
    static int grid_blocks = 0;
    if (grid_blocks == 0) {
        if (n_in != 26 || out_size != MLAT * D || ws_size < WS_END) { fprintf(stderr, "kernel_launch: unexpected shapes (n_in %d out %d ws %zu)\n", n_in, out_size, ws_size); grid_blocks = -1; return; }
        int dev = 0, cus = 0, per_cu = 0;
        (void)hipGetDevice(&dev);
        (void)hipDeviceGetAttribute(&cus, hipDeviceAttributeMultiprocessorCount, dev);
        (void)hipFuncSetAttribute((const void*)fwd_kernel, hipFuncAttributeMaxDynamicSharedMemorySize, LDS_BYTES);
        (void)hipOccupancyMaxActiveBlocksPerMultiprocessor(&per_cu, (const void*)fwd_kernel, NTHREADS, LDS_BYTES);
        (void)hipGetLastError();
        if (per_cu < 1) per_cu = 1;
        grid_blocks = cus * per_cu;
        fprintf(stderr, "kernel_launch: %d CUs x %d blocks\n", cus, per_cu);
    }
    if (grid_blocks < 0) return;
    if (hipMemsetAsync(d_ws, 0, WS_CTL_BYTES, stream) != hipSuccess) { fprintf(stderr, "kernel_launch: memset failed\n"); return; }
    Params p{};
    for (int i = 0; i < 26; ++i) p.in[i] = (const float*)d_in[i];
    p.out = (float*)d_out; p.ws = (unsigned char*)d_ws; p.ph_lo = 0; p.ph_hi = NPHASES;
    void* args[] = {&p};
    hipError_t e = hipLaunchCooperativeKernel((const void*)fwd_kernel, dim3(grid_blocks), dim3(NTHREADS), args, LDS_BYTES, stream);
    if (e != hipSuccess) fprintf(stderr, "cooperative launch failed: %s (grid %d)\n", hipGetErrorString(e), grid_blocks);
}
```

```cpp
#include <hip/hip_runtime.h>
#include <hip/hip_cooperative_groups.h>
#include <cstdio>
#include <cstdint>
namespace cg = cooperative_groups;
#ifndef FAST_QKV
#define FAST_QKV 1
#endif
#ifndef FAST_RESID
#define FAST_RESID 1
#endif
#ifndef FAST_UP
#define FAST_UP 1
#endif
#ifndef FAST_ATTN
#define FAST_ATTN 1
#endif

#define LAS __attribute__((address_space(3)))
typedef unsigned short bf16_t;
typedef short bf16x8 __attribute__((ext_vector_type(8)));
typedef float f32x4 __attribute__((ext_vector_type(4)));
typedef unsigned u32x4 __attribute__((ext_vector_type(4)));
typedef unsigned u32x2 __attribute__((ext_vector_type(2)));

constexpr int D = 1024, NB = 4, SEQ = 4096, CTX = 256, DEPTH = 4;
constexpr int MLAT = NB * SEQ, MCTX = NB * CTX, MTOT = MLAT + MCTX;
constexpr int DFF = 2816, NUP = 2 * DFF;
constexpr int NH = 16, HD = 64;
constexpr int KVROWS = SEQ + CTX;
constexpr int NWAVES = 8, NTHREADS = NWAVES * 64;
constexpr float RMS_EPS = 1e-6f;
constexpr float LOG2E = 1.4426950408889634f;
constexpr float C2 = 0.125f * LOG2E;

__host__ __device__ constexpr int kind_of(int l) { return l % 3; }
__host__ __device__ constexpr int kvw_of(int l) { return kind_of(l) == 0 ? 1024 : 256; }
__host__ __device__ constexpr int nqkv_of(int l) { return 1024 + 2 * kvw_of(l); }
__host__ __device__ constexpr size_t wl_size(int l) { return (size_t)nqkv_of(l) * D + (size_t)D * D + (size_t)NUP * D + (size_t)D * DFF; }
__host__ __device__ constexpr size_t wl_off(int l) { size_t o = 0; for (int i = 0; i < l; ++i) o += wl_size(i); return o; }

constexpr size_t MiB = 1u << 20;
constexpr size_t WS_BAR = 16384, WS_CTL_BYTES = 65536;
constexpr size_t WS_MOD = 1 * MiB;
constexpr size_t WS_ROPE = 1 * MiB + 768 * 1024;
constexpr size_t WS_STATS = 6 * MiB;
constexpr size_t WS_BQKV = 7 * MiB + 256 * 1024;
constexpr size_t WS_BUP = 7 * MiB + 512 * 1024;
constexpr size_t WS_CTXRES = 2 * MiB;
constexpr size_t WS_W = 8 * MiB;
constexpr size_t WS_H = 100 * MiB;
constexpr size_t WS_Q = 134 * MiB;
constexpr size_t WS_K = 168 * MiB;
constexpr size_t WS_V = 202 * MiB;
constexpr size_t WS_O = 236 * MiB;
constexpr size_t WS_ACT = 270 * MiB;
constexpr size_t WS_HB = 134 * MiB;
constexpr size_t WS_U = 134 * MiB;
constexpr size_t WS_END = 364 * MiB;
static_assert(WS_W + wl_off(DEPTH) * 2 <= WS_H, "weights fit");
static_assert(WS_U + (size_t)9216 * NUP * 2 <= WS_ACT, "u chunk fits");
static_assert(WS_ACT + (size_t)MTOT * DFF * 2 <= WS_END, "act fits");

struct Params { const float* in[26]; float* out; unsigned char* ws; int ph_lo, ph_hi; };

__device__ __forceinline__ int tid_opaque() { int t = threadIdx.x; asm volatile("" : "+v"(t)); return t; }
__device__ __forceinline__ unsigned f2bf(float f) { unsigned u = __builtin_bit_cast(unsigned, f); return (u + 0x7fffu + ((u >> 16) & 1u)) >> 16; }
__device__ __forceinline__ unsigned pk2(float lo, float hi) { return f2bf(lo) | (f2bf(hi) << 16); }
__device__ __forceinline__ float bf_lo(unsigned w) { return __builtin_bit_cast(float, w << 16); }
__device__ __forceinline__ float bf_hi(unsigned w) { return __builtin_bit_cast(float, w & 0xffff0000u); }
__device__ __forceinline__ float wave_sum(float v) {
#pragma unroll
    for (int o = 1; o < 64; o <<= 1) v += __shfl_xor(v, o);
    return v;
}
__device__ __forceinline__ float silu_f(float x) { return x / (1.f + __expf(-x)); }
__device__ __forceinline__ float* xrow_ptr(const Params& P, int r) { return r < MLAT ? P.out + (size_t)r * D : (float*)(P.ws + WS_CTXRES) + (size_t)(r - MLAT) * D; }
__device__ __forceinline__ int cond_idx(int r) { return r < MLAT ? (r >> 12) : 4; }
__device__ __forceinline__ size_t kv_row(int r) { return r < MLAT ? (size_t)(r >> 12) * KVROWS + (r & 4095) : (size_t)((r - MLAT) >> 8) * KVROWS + SEQ + ((r - MLAT) & 255); }
__device__ __forceinline__ const float* mod_ptr(const Params& P, int l, int ci) { return (const float*)(P.ws + WS_MOD) + (size_t)(l * 5 + ci) * 6144; }

struct LayerW { const float *wqkv, *gq, *gk, *wo, *rpb, *sink; };
__device__ __forceinline__ LayerW layer_w(const Params& P, int l) {
    LayerW w; const int kind = kind_of(l), j = l / 3;
    if (kind == 0) { w.wqkv = P.in[8] + (size_t)j * D * 3072; w.gq = P.in[9] + j * 64; w.gk = P.in[10] + j * 64; w.rpb = P.in[11] + (size_t)j * NH * 15 * 31; w.wo = P.in[12] + (size_t)j * D * D; w.sink = nullptr; }
    else if (kind == 1) { w.wqkv = P.in[13] + (size_t)j * D * 1536; w.gq = P.in[14] + j * 64; w.gk = P.in[15] + j * 64; w.sink = P.in[16] + j * NH; w.wo = P.in[17] + (size_t)j * D * D; w.rpb = nullptr; }
    else { w.wqkv = P.in[18] + (size_t)j * D * 1536; w.gq = P.in[19] + j * 64; w.gk = P.in[20] + j * 64; w.wo = P.in[21] + (size_t)j * D * D; w.rpb = nullptr; w.sink = nullptr; }
    return w;
}
__device__ __forceinline__ bf16_t* wt_qkv(const Params& P, int l) { return (bf16_t*)(P.ws + WS_W) + wl_off(l); }
__device__ __forceinline__ bf16_t* wt_o(const Params& P, int l) { return wt_qkv(P, l) + (size_t)nqkv_of(l) * D; }
__device__ __forceinline__ bf16_t* wt_up(const Params& P, int l) { return wt_o(P, l) + (size_t)D * D; }
__device__ __forceinline__ bf16_t* wt_dn(const Params& P, int l) { return wt_up(P, l) + (size_t)NUP * D; }

__device__ __forceinline__ int phys_qkv(int c) { return (c & ~255) + 128 * ((c >> 5) & 1) + 32 * ((c >> 6) & 3) + (c & 31); }
__device__ __forceinline__ int phys_up(int c) { const int bj = c >= DFF ? 1 : 0, cc = c - bj * DFF; return 256 * (cc >> 7) + 128 * bj + (cc & 127); }

__device__ __forceinline__ void transpose_item(const float* W, int K, int N, bf16_t* WT, int mode, LAS float* scr, int item, int lane) {
    const int nblk = N / 32, kb = item / nblk, nb = item % nblk, k0 = 64 * kb, n0 = 32 * nb;
#pragma unroll 8
    for (int i = 0; i < 32; ++i) { const int kk = 2 * i + (lane >> 5); scr[kk * 33 + (lane & 31)] = W[(size_t)(k0 + kk) * N + n0 + (lane & 31)]; }
    asm volatile("s_waitcnt lgkmcnt(0)" ::: "memory");
    const int p0 = mode == 1 ? phys_qkv(n0) : (mode == 2 ? phys_up(n0) : n0);
    const int c = lane & 7;
#pragma unroll
    for (int j = 0; j < 4; ++j) { const int n = (lane >> 3) + 8 * j; const LAS float* s = scr + (8 * c) * 33 + n;
        u32x4 o; o.x = pk2(s[0 * 33], s[1 * 33]); o.y = pk2(s[2 * 33], s[3 * 33]); o.z = pk2(s[4 * 33], s[5 * 33]); o.w = pk2(s[6 * 33], s[7 * 33]);
        *(u32x4*)(WT + (size_t)(p0 + n) * K + k0 + 8 * c) = o; }
    asm volatile("s_waitcnt lgkmcnt(0)" ::: "memory");
}

template <int L> __device__ __forceinline__ void prologue_weights(const Params& P, LAS float* scr, int gw, int NGW, int lane) {
    const LayerW lw = layer_w(P, L); constexpr int nq = nqkv_of(L);
    constexpr int I_Q = (D / 64) * (nq / 32), I_O = (D / 64) * (D / 32), I_U = (D / 64) * (NUP / 32), I_D = (DFF / 64) * (D / 32);
    constexpr int NIT = I_Q + I_O + I_U + I_D;
    for (int it = gw; it < NIT; it += NGW) {
        int r = it;
        if (r < I_Q) { transpose_item(lw.wqkv, D, nq, wt_qkv(P, L), 1, scr, r, lane); continue; } r -= I_Q;
        if (r < I_O) { transpose_item(lw.wo, D, D, wt_o(P, L), 0, scr, r, lane); continue; } r -= I_O;
        if (r < I_U) { transpose_item(P.in[22] + (size_t)L * D * NUP, D, NUP, wt_up(P, L), 2, scr, r, lane); continue; } r -= I_U;
        transpose_item(P.in[25] + (size_t)L * DFF * D, DFF, D, wt_dn(P, L), 0, scr, r, lane);
    }
}

__device__ __forceinline__ void ph_prologue(const Params& P, LAS unsigned char* lds) {
    const int tid = tid_opaque(), wave = __builtin_amdgcn_readfirstlane(tid >> 6), lane = tid & 63;
    if (blockIdx.x == 0) {
        float* tab = (float*)(P.ws + WS_ROPE);
        for (int idx = tid; idx < 64 * 16; idx += NTHREADS) { const int pos = idx >> 4, f = idx & 15;
            const float inv = powf(10000.0f, -(float)f / 16.0f); const float ang = (float)pos * inv;
            tab[2 * idx] = cosf(ang); tab[2 * idx + 1] = sinf(ang); }
    }
    {
        LAS float* sil = (LAS float*)lds;
        LAS float* part = (LAS float*)(lds + 20480);
        for (int i = tid; i < 5 * 1024; i += NTHREADS) { const int ci = i >> 10, k = i & 1023; const float c = ci < 4 ? P.in[1][ci * D + k] : P.in[3][k]; sil[i] = silu_f(c); }
        __syncthreads();
        for (int it = blockIdx.x; it < DEPTH * 96; it += gridDim.x) {
            const int l = it / 96, n = (it % 96) * 64 + lane;
            const float* w = P.in[4] + (size_t)l * D * 6144 + n;
            float a0 = 0.f, a1 = 0.f, a2 = 0.f, a3 = 0.f, a4 = 0.f;
            const int kbeg = wave * 128;
#pragma unroll 8
            for (int k = kbeg; k < kbeg + 128; ++k) { const float wv = w[(size_t)k * 6144];
                a0 += sil[k] * wv; a1 += sil[1024 + k] * wv; a2 += sil[2048 + k] * wv; a3 += sil[3072 + k] * wv; a4 += sil[4096 + k] * wv; }
            part[(wave * 5 + 0) * 64 + lane] = a0; part[(wave * 5 + 1) * 64 + lane] = a1; part[(wave * 5 + 2) * 64 + lane] = a2; part[(wave * 5 + 3) * 64 + lane] = a3; part[(wave * 5 + 4) * 64 + lane] = a4;
            __syncthreads();
            if (tid < 320) { const int ci = tid >> 6, ln = tid & 63; float s = 0.f;
#pragma unroll
                for (int w8 = 0; w8 < 8; ++w8) s += part[(w8 * 5 + ci) * 64 + ln];
                const int nn = (it % 96) * 64 + ln;
                ((float*)(P.ws + WS_MOD))[(size_t)(l * 5 + ci) * 6144 + nn] = s + P.in[5][l * 6144 + nn]; }
            __syncthreads();
        }
    }
    const int gw = blockIdx.x * NWAVES + wave, NGW = gridDim.x * NWAVES;
    {
        LAS float* scr = (LAS float*)(lds + 32768 + wave * 8704);
        prologue_weights<0>(P, scr, gw, NGW, lane); prologue_weights<1>(P, scr, gw, NGW, lane);
        prologue_weights<2>(P, scr, gw, NGW, lane); prologue_weights<3>(P, scr, gw, NGW, lane);
    }
}


template <int L> __device__ __forceinline__ void prologue_bias(const Params& P, int gw, int NGW, int lane) {
    constexpr int nq = nqkv_of(L), NIT = (nq + NUP) / 8;
    for (int it = gw; it < NIT; it += NGW) {
        const int p0 = it * 8; const bool isq = p0 < nq;
        const bf16_t* W = isq ? wt_qkv(P, L) + (size_t)p0 * D : wt_up(P, L) + (size_t)(p0 - nq) * D;
        float* dst = isq ? (float*)(P.ws + WS_BQKV) + (size_t)L * 5 * 3072 + p0 : (float*)(P.ws + WS_BUP) + (size_t)L * 5 * NUP + (p0 - nq);
        const int dstride = isq ? nq : NUP;
        f32x4 sh[5][4];
#pragma unroll
        for (int ci = 0; ci < 5; ++ci) { const float* sp = mod_ptr(P, L, ci) + (isq ? 0 : 3072) + 16 * lane;
#pragma unroll
            for (int q = 0; q < 4; ++q) sh[ci][q] = *(const f32x4*)(sp + 4 * q); }
        for (int rr = 0; rr < 8; ++rr) {
            const u32x4 w0 = *(const u32x4*)(W + (size_t)rr * D + 16 * lane), w1 = *(const u32x4*)(W + (size_t)rr * D + 16 * lane + 8);
            const f32x4 wf[4] = {(f32x4){bf_lo(w0.x), bf_hi(w0.x), bf_lo(w0.y), bf_hi(w0.y)}, (f32x4){bf_lo(w0.z), bf_hi(w0.z), bf_lo(w0.w), bf_hi(w0.w)},
                                 (f32x4){bf_lo(w1.x), bf_hi(w1.x), bf_lo(w1.y), bf_hi(w1.y)}, (f32x4){bf_lo(w1.z), bf_hi(w1.z), bf_lo(w1.w), bf_hi(w1.w)}};
#pragma unroll
            for (int ci = 0; ci < 5; ++ci) { f32x4 a = sh[ci][0] * wf[0] + sh[ci][1] * wf[1] + sh[ci][2] * wf[2] + sh[ci][3] * wf[3];
                const float t = wave_sum((a.x + a.y) + (a.z + a.w));
                if (lane == 0) dst[(size_t)ci * dstride + rr] = t; }
        }
    }
}

__device__ __forceinline__ void ph_prologue_b(const Params& P) {
    const int tid = tid_opaque(), wave = __builtin_amdgcn_readfirstlane(tid >> 6), lane = tid & 63;
    const int gw = blockIdx.x * NWAVES + wave, NGW = gridDim.x * NWAVES;
    bf16_t* H = (bf16_t*)(P.ws + WS_H); float* stats = (float*)(P.ws + WS_STATS);
    const float* g = P.in[6];
    for (int r = gw; r < MTOT; r += NGW) {
        const f32x4* xs = (r < MLAT ? (const f32x4*)(P.in[0] + (size_t)r * D) : (const f32x4*)(P.in[2] + (size_t)(r - MLAT) * D)) + lane;
        f32x4* xd = (f32x4*)xrow_ptr(P, r) + lane;
        const float* md = mod_ptr(P, 0, cond_idx(r));
        u32x2* o8 = (u32x2*)(H + (size_t)r * D) + lane;
        float ss = 0.f;
#pragma unroll
        for (int j = 0; j < 4; ++j) { const f32x4 v = xs[64 * j]; xd[64 * j] = v; ss += (v.x * v.x + v.y * v.y) + (v.z * v.z + v.w * v.w);
            const int c = 4 * lane + 256 * j; const f32x4 gg = *(const f32x4*)(g + c), sc = *(const f32x4*)(md + 1024 + c);
            const f32x4 hh = v * (gg * (sc + 1.0f)); u32x2 w; w.x = pk2(hh.x, hh.y); w.y = pk2(hh.z, hh.w); o8[64 * j] = w; }
        ss = wave_sum(ss);
        if (lane < 16) stats[(size_t)r * 16 + lane] = lane == 0 ? ss : 0.f;
    }
    prologue_bias<0>(P, gw, NGW, lane); prologue_bias<1>(P, gw, NGW, lane); prologue_bias<2>(P, gw, NGW, lane); prologue_bias<3>(P, gw, NGW, lane);
}

__device__ __forceinline__ void ph_norm(const Params& P, int l, int which, int nrows, int wave, int lane) {
    const int gw = blockIdx.x * NWAVES + wave, NGW = gridDim.x * NWAVES;
    const float* g = (which == 0 ? P.in[6] : P.in[7]) + l * D;
    bf16_t* H = (bf16_t*)(P.ws + WS_H);
    for (int r = gw; r < nrows; r += NGW) {
        const f32x4* xr = (const f32x4*)xrow_ptr(P, r) + lane;
        const float* md = mod_ptr(P, l, cond_idx(r)) + (which == 0 ? 0 : 3072);
        f32x4 v[4]; float s = 0.f;
#pragma unroll
        for (int j = 0; j < 4; ++j) { v[j] = xr[64 * j]; s += (v[j].x * v[j].x + v[j].y * v[j].y) + (v[j].z * v[j].z + v[j].w * v[j].w); }
        const float rstd = 1.0f / sqrtf(wave_sum(s) * (1.f / D) + RMS_EPS);
        u32x2* o8 = (u32x2*)(H + (size_t)r * D) + lane;
#pragma unroll
        for (int j = 0; j < 4; ++j) { const int c = 4 * lane + 256 * j;
            const f32x4 gg = *(const f32x4*)(g + c), sh = *(const f32x4*)(md + c), sc = *(const f32x4*)(md + 1024 + c);
            const f32x4 y = (v[j] * rstd) * gg;
            const f32x4 hh = y * (sc + 1.0f) + sh;
            u32x2 w; w.x = pk2(hh.x, hh.y); w.y = pk2(hh.z, hh.w); o8[64 * j] = w; }
    }
}

__device__ __forceinline__ void wave_gemm(const bf16_t* a0p, const bf16_t* a1p, const bf16_t* b0, const bf16_t* b1, const bf16_t* b2, const bf16_t* b3, int K, f32x4 (&acc)[2][4]) {
#pragma unroll
    for (int m = 0; m < 2; ++m)
#pragma unroll
        for (int n = 0; n < 4; ++n) acc[m][n] = (f32x4){0.f, 0.f, 0.f, 0.f};
#pragma unroll 2
    for (int k = 0; k < K; k += 32) {
        const bf16x8 a0 = *(const bf16x8*)(a0p + k), a1 = *(const bf16x8*)(a1p + k);
        const bf16x8 w0 = *(const bf16x8*)(b0 + k), w1 = *(const bf16x8*)(b1 + k), w2 = *(const bf16x8*)(b2 + k), w3 = *(const bf16x8*)(b3 + k);
        acc[0][0] = __builtin_amdgcn_mfma_f32_16x16x32_bf16(w0, a0, acc[0][0], 0, 0, 0);
        acc[0][1] = __builtin_amdgcn_mfma_f32_16x16x32_bf16(w1, a0, acc[0][1], 0, 0, 0);
        acc[0][2] = __builtin_amdgcn_mfma_f32_16x16x32_bf16(w2, a0, acc[0][2], 0, 0, 0);
        acc[0][3] = __builtin_amdgcn_mfma_f32_16x16x32_bf16(w3, a0, acc[0][3], 0, 0, 0);
        acc[1][0] = __builtin_amdgcn_mfma_f32_16x16x32_bf16(w0, a1, acc[1][0], 0, 0, 0);
        acc[1][1] = __builtin_amdgcn_mfma_f32_16x16x32_bf16(w1, a1, acc[1][1], 0, 0, 0);
        acc[1][2] = __builtin_amdgcn_mfma_f32_16x16x32_bf16(w2, a1, acc[1][2], 0, 0, 0);
        acc[1][3] = __builtin_amdgcn_mfma_f32_16x16x32_bf16(w3, a1, acc[1][3], 0, 0, 0);
    }
}

__device__ __forceinline__ void ph_qkv(const Params& P, int l, int wave, int lane) {
    const int gw = blockIdx.x * NWAVES + wave, NGW = gridDim.x * NWAVES;
    const int kind = kind_of(l), kvw = kvw_of(l), nkvh = kvw / 64, nheads = 16 + 2 * nkvh;
    const bool last = (l == DEPTH - 1);
    const LayerW lw = layer_w(P, l);
    const bf16_t* H = (const bf16_t*)(P.ws + WS_H); const bf16_t* W = wt_qkv(P, l);
    bf16_t* Qb = (bf16_t*)(P.ws + WS_Q); bf16_t* Kb = (bf16_t*)(P.ws + WS_K); bf16_t* Vb = (bf16_t*)(P.ws + WS_V);
    const float* rope = (const float*)(P.ws + WS_ROPE);
    const int fr = lane & 15, fq = lane >> 4;
    const int nitems = (MTOT / 32) * nheads;
    for (int it = gw; it < nitems; it += NGW) {
        const int rb = it / nheads, hh = it % nheads, row0 = rb * 32;
        if (last && row0 >= MLAT && hh < 16) continue;
        const bf16_t* a0p = H + (size_t)(row0 + fr) * D + fq * 8; const bf16_t* a1p = a0p + (size_t)16 * D;
        const bf16_t* bp[4];
#pragma unroll
        for (int nt = 0; nt < 4; ++nt) { const int p = 256 * (hh >> 2) + 128 * (nt >> 1) + 32 * (hh & 3) + 16 * (nt & 1) + fr; bp[nt] = W + (size_t)p * D + fq * 8; }
        f32x4 acc[2][4];
        wave_gemm(a0p, a1p, bp[0], bp[1], bp[2], bp[3], D, acc);
        const int type = hh < 16 ? 0 : (hh < 16 + nkvh ? 1 : 2);
        const int hidx = type == 0 ? hh : (type == 1 ? hh - 16 : hh - 16 - nkvh);
#pragma unroll
        for (int mt = 0; mt < 2; ++mt) {
            const int row = row0 + 16 * mt + fr;
            f32x4 v[4];
#pragma unroll
            for (int nt = 0; nt < 4; ++nt) v[nt] = acc[mt][nt];
            if (type < 2) {
                float ss = 0.f;
#pragma unroll
                for (int nt = 0; nt < 4; ++nt) ss += (v[nt].x * v[nt].x + v[nt].y * v[nt].y) + (v[nt].z * v[nt].z + v[nt].w * v[nt].w);
                ss += __shfl_xor(ss, 16); ss += __shfl_xor(ss, 32);
                const float rinv = 1.0f / sqrtf(ss * (1.f / 64.f) + RMS_EPS);
                const float* gg = type == 0 ? lw.gq : lw.gk;
#pragma unroll
                for (int nt = 0; nt < 4; ++nt) { const f32x4 g4 = *(const f32x4*)(gg + 16 * nt + 4 * fq); v[nt] = (v[nt] * rinv) * g4; }
                if (kind != 0 && row < MLAT) {
                    const int t = row & 4095, prow = t >> 6, pcol = t & 63;
#pragma unroll
                    for (int nt = 0; nt < 2; ++nt) {
                        const float* tb = rope + ((nt == 0 ? prow : pcol) * 16 + 4 * fq) * 2;
                        const f32x4 t0 = *(const f32x4*)tb, t1 = *(const f32x4*)(tb + 4);
                        const f32x4 cs = (f32x4){t0.x, t0.z, t1.x, t1.z}, sn = (f32x4){t0.y, t0.w, t1.y, t1.w};
                        const f32x4 x1 = v[nt], x2 = v[nt + 2];
                        v[nt] = x1 * cs - x2 * sn; v[nt + 2] = x2 * cs + x1 * sn;
                    }
                }
                if (type == 0) {
#pragma unroll
                    for (int nt = 0; nt < 4; ++nt) v[nt] = v[nt] * C2;
                }
            }
            bf16_t* dst;
            if (type == 0) dst = Qb + (size_t)row * D + hidx * 64;
            else dst = (type == 1 ? Kb : Vb) + kv_row(row) * kvw + hidx * 64;
#pragma unroll
            for (int nt = 0; nt < 4; ++nt) { u32x2 w; w.x = pk2(v[nt].x, v[nt].y); w.y = pk2(v[nt].z, v[nt].w); *(u32x2*)(dst + 16 * nt + 4 * fq) = w; }
        }
    }
}

__device__ __forceinline__ void ph_resid_gemm(const Params& P, int l, const bf16_t* A, int K, const bf16_t* W, int gate_off, int nrows, int wave, int lane) {
    const int gw = blockIdx.x * NWAVES + wave, NGW = gridDim.x * NWAVES;
    const int fr = lane & 15, fq = lane >> 4;
    const int nitems = (nrows / 32) * 16;
    for (int it = gw; it < nitems; it += NGW) {
        const int rb = it >> 4, cb = it & 15, row0 = rb * 32, c0 = cb * 64;
        const bf16_t* a0p = A + (size_t)(row0 + fr) * K + fq * 8; const bf16_t* a1p = a0p + (size_t)16 * K;
        const bf16_t* bp = W + (size_t)(c0 + fr) * K + fq * 8;
        f32x4 acc[2][4];
        wave_gemm(a0p, a1p, bp, bp + (size_t)16 * K, bp + (size_t)32 * K, bp + (size_t)48 * K, K, acc);
        const float* gate = mod_ptr(P, l, cond_idx(row0)) + gate_off;
#pragma unroll
        for (int mt = 0; mt < 2; ++mt) { float* xr = xrow_ptr(P, row0 + 16 * mt + fr);
#pragma unroll
            for (int nt = 0; nt < 4; ++nt) { const int c = c0 + 16 * nt + 4 * fq; const f32x4 g4 = *(const f32x4*)(gate + c); f32x4* xp = (f32x4*)(xr + c); *xp = *xp + g4 * acc[mt][nt]; } }
    }
}

__device__ __forceinline__ void ph_up_gemm(const Params& P, int l, int r0, int nrows, int wave, int lane) {
    const int gw = blockIdx.x * NWAVES + wave, NGW = gridDim.x * NWAVES;
    const int fr = lane & 15, fq = lane >> 4;
    const bf16_t* H = (const bf16_t*)(P.ws + WS_H); const bf16_t* W = wt_up(P, l); bf16_t* U = (bf16_t*)(P.ws + WS_U);
    const int nitems = (nrows / 32) * (NUP / 64);
    for (int it = gw; it < nitems; it += NGW) {
        const int rb = it / (NUP / 64), cb = it % (NUP / 64), row0 = r0 + rb * 32, c0 = cb * 64;
        const bf16_t* a0p = H + (size_t)(row0 + fr) * D + fq * 8; const bf16_t* a1p = a0p + (size_t)16 * D;
        const bf16_t* bp = W + (size_t)(c0 + fr) * D + fq * 8;
        f32x4 acc[2][4];
        wave_gemm(a0p, a1p, bp, bp + (size_t)16 * D, bp + (size_t)32 * D, bp + (size_t)48 * D, D, acc);
#pragma unroll
        for (int mt = 0; mt < 2; ++mt) { bf16_t* ur = U + (size_t)(row0 - r0 + 16 * mt + fr) * NUP + c0;
#pragma unroll
            for (int nt = 0; nt < 4; ++nt) { u32x2 w; w.x = pk2(acc[mt][nt].x, acc[mt][nt].y); w.y = pk2(acc[mt][nt].z, acc[mt][nt].w); *(u32x2*)(ur + 16 * nt + 4 * fq) = w; } }
    }
}

__device__ __forceinline__ void ph_conv(const Params& P, int l, int r0, int nrows) {
    const int gt = blockIdx.x * NTHREADS + threadIdx.x, NGT = gridDim.x * NTHREADS;
    const bf16_t* U = (const bf16_t*)(P.ws + WS_U); bf16_t* ACT = (bf16_t*)(P.ws + WS_ACT);
    const float* cw = P.in[23] + (size_t)l * 3 * NUP; const float* cb = P.in[24] + (size_t)l * NUP;
    const int per_row = DFF / 8;
    for (int i = gt; i < nrows * per_row; i += NGT) {
        const int rr = i / per_row, c = (i % per_row) * 8, row = r0 + rr;
        const int pos = row < MLAT ? (row & 4095) : ((row - MLAT) & 255), slen = row < MLAT ? SEQ : CTX;
        const int pa = 256 * (c >> 7) + (c & 127);
        float av[8], gv[8];
#pragma unroll
        for (int e = 0; e < 8; ++e) { av[e] = cb[c + e]; gv[e] = cb[DFF + c + e]; }
#pragma unroll
        for (int tap = 0; tap < 3; ++tap) {
            const int pp = pos + tap - 1;
            if (pp < 0 || pp >= slen) continue;
            const bf16_t* ur = U + (size_t)(rr + tap - 1) * NUP + pa;
            const u32x4 ua = *(const u32x4*)ur, ug = *(const u32x4*)(ur + 128);
            const float* wa = cw + tap * NUP + c; const float* wg = wa + DFF;
            av[0] += wa[0] * bf_lo(ua.x); av[1] += wa[1] * bf_hi(ua.x); av[2] += wa[2] * bf_lo(ua.y); av[3] += wa[3] * bf_hi(ua.y);
            av[4] += wa[4] * bf_lo(ua.z); av[5] += wa[5] * bf_hi(ua.z); av[6] += wa[6] * bf_lo(ua.w); av[7] += wa[7] * bf_hi(ua.w);
            gv[0] += wg[0] * bf_lo(ug.x); gv[1] += wg[1] * bf_hi(ug.x); gv[2] += wg[2] * bf_lo(ug.y); gv[3] += wg[3] * bf_hi(ug.y);
            gv[4] += wg[4] * bf_lo(ug.z); gv[5] += wg[5] * bf_hi(ug.z); gv[6] += wg[6] * bf_lo(ug.w); gv[7] += wg[7] * bf_hi(ug.w);
        }
        u32x4 o;
        o.x = pk2(av[0] * silu_f(gv[0]), av[1] * silu_f(gv[1])); o.y = pk2(av[2] * silu_f(gv[2]), av[3] * silu_f(gv[3]));
        o.z = pk2(av[4] * silu_f(gv[4]), av[5] * silu_f(gv[5])); o.w = pk2(av[6] * silu_f(gv[6]), av[7] * silu_f(gv[7]));
        *(u32x4*)(ACT + (size_t)row * DFF + c) = o;
    }
}

__device__ __forceinline__ void attn_key(const bf16_t* kp, const bf16_t* vp, const unsigned (&q)[32], float (&o)[64], float& m, float& l, bool valid, float bias) {
    float s0 = 0.f, s1 = 0.f;
#pragma unroll
    for (int c = 0; c < 8; ++c) { const u32x4 kk = *(const u32x4*)(kp + 8 * c);
        s0 += bf_lo(q[4 * c + 0]) * bf_lo(kk.x); s1 += bf_hi(q[4 * c + 0]) * bf_hi(kk.x); s0 += bf_lo(q[4 * c + 1]) * bf_lo(kk.y); s1 += bf_hi(q[4 * c + 1]) * bf_hi(kk.y);
        s0 += bf_lo(q[4 * c + 2]) * bf_lo(kk.z); s1 += bf_hi(q[4 * c + 2]) * bf_hi(kk.z); s0 += bf_lo(q[4 * c + 3]) * bf_lo(kk.w); s1 += bf_hi(q[4 * c + 3]) * bf_hi(kk.w); }
    float s = (s0 + s1) + bias; if (!valid) s = -1e30f;
    const float mn = fmaxf(m, s), a = __builtin_amdgcn_exp2f(m - mn), p = __builtin_amdgcn_exp2f(s - mn);
    l = l * a + p; m = mn;
#pragma unroll
    for (int c = 0; c < 8; ++c) { const u32x4 vv = *(const u32x4*)(vp + 8 * c);
        o[8 * c + 0] = o[8 * c + 0] * a + p * bf_lo(vv.x); o[8 * c + 1] = o[8 * c + 1] * a + p * bf_hi(vv.x); o[8 * c + 2] = o[8 * c + 2] * a + p * bf_lo(vv.y); o[8 * c + 3] = o[8 * c + 3] * a + p * bf_hi(vv.y);
        o[8 * c + 4] = o[8 * c + 4] * a + p * bf_lo(vv.z); o[8 * c + 5] = o[8 * c + 5] * a + p * bf_hi(vv.z); o[8 * c + 6] = o[8 * c + 6] * a + p * bf_lo(vv.w); o[8 * c + 7] = o[8 * c + 7] * a + p * bf_hi(vv.w); }
}

__device__ __forceinline__ void ph_attn(const Params& P, int l, int wave, int lane) {
    const int gw = blockIdx.x * NWAVES + wave, NGW = gridDim.x * NWAVES;
    const int kind = kind_of(l), kvw = kvw_of(l);
    const bool last = (l == DEPTH - 1);
    const LayerW lw = layer_w(P, l);
    const bf16_t* Qb = (const bf16_t*)(P.ws + WS_Q); const bf16_t* Kb = (const bf16_t*)(P.ws + WS_K); const bf16_t* Vb = (const bf16_t*)(P.ws + WS_V);
    bf16_t* Ob = (bf16_t*)(P.ws + WS_O);
    const int nrows = last ? MLAT : MTOT;
    const int nitems = (nrows / 64) * NH;
    for (int it = gw; it < nitems; it += NGW) {
        const int h = it & 15, rblk = it >> 4, row0 = rblk * 64, row = row0 + lane;
        const bool isctx = row0 >= MLAT;
        const int b = isctx ? ((row0 - MLAT) >> 8) : (row0 >> 12);
        const int kvh = kind == 0 ? h : (h >> 2);
        const bf16_t* Kbase = Kb + (size_t)b * KVROWS * kvw + kvh * 64; const bf16_t* Vbase = Vb + (size_t)b * KVROWS * kvw + kvh * 64;
        unsigned q[32]; float o[64];
        { const bf16_t* qp = Qb + (size_t)row * D + h * 64;
#pragma unroll
          for (int c = 0; c < 8; ++c) { const u32x4 w = *(const u32x4*)(qp + 8 * c); q[4 * c + 0] = w.x; q[4 * c + 1] = w.y; q[4 * c + 2] = w.z; q[4 * c + 3] = w.w; } }
#pragma unroll
        for (int d = 0; d < 64; ++d) o[d] = 0.f;
        float m = -1e30f, lsum = 0.f;
        for (int j = SEQ; j < KVROWS; ++j) attn_key(Kbase + (size_t)j * kvw, Vbase + (size_t)j * kvw, q, o, m, lsum, true, 0.f);
        if (!isctx) {
            const int t0 = row0 & 4095, t = t0 + lane;
            if (kind == 2) {
                for (int j = 0; j < SEQ; ++j) attn_key(Kbase + (size_t)j * kvw, Vbase + (size_t)j * kvw, q, o, m, lsum, true, 0.f);
            } else if (kind == 1) {
                const int jlo = t0 - 128 < 0 ? 0 : t0 - 128, jhi = t0 + 64 + 128 > SEQ ? SEQ : t0 + 64 + 128;
                for (int j = jlo; j < jhi; ++j) { const int dd = j - t; attn_key(Kbase + (size_t)j * kvw, Vbase + (size_t)j * kvw, q, o, m, lsum, dd >= -128 && dd <= 128, 0.f); }
            } else {
                const int r = t0 >> 6, c = lane;
                int rs = r - 4; rs = rs < 0 ? 0 : (rs > 56 ? 56 : rs);
                int cs = c - 8; cs = cs < 0 ? 0 : (cs > 48 ? 48 : cs);
                const float* rp = lw.rpb + (size_t)h * 15 * 31;
                for (int kr = rs; kr < rs + 8; ++kr) {
                    const float* rrow = rp + (kr - r + 7) * 31;
                    for (int kc = 0; kc < 64; ++kc) {
                        const bool valid = (kc >= cs) && (kc < cs + 16);
                        int dc = kc - c; dc = dc < -15 ? -15 : (dc > 15 ? 15 : dc);
                        const float bias = rrow[dc + 15] * LOG2E;
                        const int j = kr * 64 + kc;
                        attn_key(Kbase + (size_t)j * kvw, Vbase + (size_t)j * kvw, q, o, m, lsum, valid, bias);
                    }
                }
            }
        }
        if (kind == 1) lsum += __builtin_amdgcn_exp2f(lw.sink[h] * LOG2E - m);
        const float inv = 1.0f / lsum;
        bf16_t* op = Ob + (size_t)row * D + h * 64;
#pragma unroll
        for (int c = 0; c < 8; ++c) { u32x4 w; w.x = pk2(o[8 * c + 0] * inv, o[8 * c + 1] * inv); w.y = pk2(o[8 * c + 2] * inv, o[8 * c + 3] * inv); w.z = pk2(o[8 * c + 4] * inv, o[8 * c + 5] * inv); w.w = pk2(o[8 * c + 6] * inv, o[8 * c + 7] * inv);
            *(u32x4*)(op + 8 * c) = w; }
    }
}

namespace pg8 {
#define PG8_LAS __attribute__((address_space(3)))
typedef unsigned short bf16_t;
typedef short bf16x8 __attribute__((ext_vector_type(8)));
typedef float f32x4 __attribute__((ext_vector_type(4)));
typedef unsigned u32x4 __attribute__((ext_vector_type(4)));
constexpr int BM = 256, BK = 64, HALF = 128, HTB = HALF * BK * 2  , STAGE_BYTES = 8 * HTB, NXCD = 8, WGM = 8;

__host__ __device__ __forceinline__ int lds_byte(int r, int c) { const int st = (r >> 4) * 2 + (c >> 5), rr = r & 15, cc = c & 31, ob = rr * 64 + cc * 2; return st * 1024 + (ob ^ (((ob >> 9) & 1) << 5)); }
__host__ __device__ __forceinline__ void stage_rc(int b, int& R, int& C) { const int st = b / 1024, sb = b % 1024, swz = sb ^ (((sb >> 9) & 1) << 5); R = (st >> 1) * 16 + swz / 64; C = (st & 1) * 32 + (swz % 64) / 2; }
__host__ __device__ __forceinline__ int perm32(int rho) { const int n = rho >> 4, i = rho & 15; return 8 * (i >> 2) + 4 * n + (i & 3); }

struct Unit { int pm, pn; };
struct Gemm { const bf16_t* A; const bf16_t* Bt; int M, N, K; };

struct StaticOrder {
    int nM, nN, nwg, G, c;
    __host__ __device__ void init(int M, int N, int G_, int c_) { nM = M / BM; nN = N / BM; nwg = nM * nN; G = G_; c = c_; }
    __host__ __device__ bool next(int i, Unit& u) const {
        const long L = (long)i * G + c; if (L >= nwg) return false;
        int wgid = (int)L; { const int q = nwg / NXCD, r = nwg % NXCD, xcd = wgid % NXCD, off = wgid / NXCD; wgid = (xcd < r ? xcd * (q + 1) : r * (q + 1) + (xcd - r) * q) + off; }
        const int nig = WGM * nN, gid = wgid / nig, fm = gid * WGM, gsz = (nM - fm) < WGM ? (nM - fm) : WGM;
        u.pm = fm + ((wgid % nig) % gsz); u.pn = (wgid % nig) / gsz; return true;
    }
    __device__ __forceinline__ void a_ready(const Unit&) const {}
    __device__ __forceinline__ void done(const Unit&) const {}
};
template <class Epi, class Sched, bool ALIGN_EPI = false, bool SP2 = false>
__device__ __forceinline__ void gemm_phase(PG8_LAS unsigned char* lds, const Gemm g, const Sched& S, const Epi& E) {
    const int tid = tid_opaque(), wid = __builtin_amdgcn_readfirstlane(tid >> 6), lane = tid & 63, wr = wid >> 2, wc = wid & 3, fr = lane & 15, fq = lane >> 4;
    const int K = g.K, nt = K / BK;
    unsigned voffA[2], voffB[2];
#pragma unroll
    for (int i = 0; i < 2; ++i) { int R, C; stage_rc(tid * 16 + i * 8192, R, C); const int Rb = Epi::PERM ? ((R & ~31) + perm32(R & 31)) : R;
        voffA[i] = (unsigned)(R * K + C) * 2u; voffB[i] = (unsigned)(Rb * K + C) * 2u; }
    const size_t kstep = (size_t)(BK * 2);
    const size_t hstep = (size_t)HALF * K * 2;
    const size_t tstep = 2 * hstep;
    const unsigned ldsw = (unsigned)wid * 1024u;
    const int aoff = lds_byte(wr * 64 + fr, fq * 8), boff = lds_byte(wc * 32 + fr, fq * 8);
#define PG8_SA(b, h) (((b) * 2 + (h)) * HTB)
#define PG8_SB(b, h) ((4 + (b) * 2 + (h)) * HTB)
#define PG8_STAGE(bufoff, gbase, voff) do { _Pragma("unroll") for (int _i = 0; _i < 2; ++_i) \
        __builtin_amdgcn_global_load_lds((const unsigned*)((const char*)(gbase) + (voff)[_i]), (PG8_LAS unsigned*)(lds + (bufoff) + ldsw + _i * 8192), 16, 0, 0); } while (0)
#define PG8_LDA(dst, b, h) do { _Pragma("unroll") for (int m = 0; m < 4; ++m) _Pragma("unroll") for (int k = 0; k < 2; ++k) dst[m][k] = *(const PG8_LAS bf16x8*)(lds + PG8_SA(b, h) + aoff + m * 2048 + k * 1024); } while (0)
#define PG8_LDB(dst, b, h) do { _Pragma("unroll") for (int n = 0; n < 2; ++n) _Pragma("unroll") for (int k = 0; k < 2; ++k) dst[n][k] = *(const PG8_LAS bf16x8*)(lds + PG8_SB(b, h) + boff + n * 2048 + k * 1024); } while (0)
#define PG8_MMA(ai, bj, At, Bt) do { __builtin_amdgcn_s_setprio(1); _Pragma("unroll") for (int m = 0; m < 4; ++m) _Pragma("unroll") for (int n = 0; n < 2; ++n) _Pragma("unroll") for (int k = 0; k < 2; ++k) \
        acc[ai][bj][m][n] = __builtin_amdgcn_mfma_f32_16x16x32_bf16(Bt[n][k], At[m][k], acc[ai][bj][m][n], 0, 0, 0); __builtin_amdgcn_s_setprio(0); } while (0)
#define PG8_WAIT_V(n) asm volatile("s_waitcnt vmcnt(" #n ")" ::: "memory")
#define PG8_WAIT_L(n) asm volatile("s_waitcnt lgkmcnt(" #n ")" ::: "memory")
#define PG8_BAR __builtin_amdgcn_s_barrier()
#define PG8_SCHED __builtin_amdgcn_sched_barrier(0)
    Unit cur, nxt; int ui = 0;
    if (!S.next(0, cur)) return;
    f32x4 acc[2][2][4][2];
#pragma unroll
    for (int a = 0; a < 2; ++a)
#pragma unroll
        for (int b = 0; b < 2; ++b)
#pragma unroll
            for (int m = 0; m < 4; ++m)
#pragma unroll
                for (int n = 0; n < 2; ++n) acc[a][b][m][n] = (f32x4){0.f, 0.f, 0.f, 0.f};
    bf16x8 At[4][2], B0[2][2], B1[2][2];
    const char* cA = (const char*)g.A + (size_t)cur.pm * tstep; const char* cB = (const char*)g.Bt + (size_t)cur.pn * tstep;
    S.a_ready(cur);
    if constexpr (SP2) {
        PG8_STAGE(PG8_SB(0, 0), cB, voffB); PG8_STAGE(PG8_SB(0, 1), cB + hstep, voffB); PG8_STAGE(PG8_SA(0, 0), cA, voffA); PG8_STAGE(PG8_SA(0, 1), cA + hstep, voffA);
        if (wr == 1) PG8_BAR;
        PG8_WAIT_V(2); PG8_BAR;
        PG8_STAGE(PG8_SB(1, 0), cB + kstep, voffB); PG8_STAGE(PG8_SA(1, 0), cA + kstep, voffA); PG8_STAGE(PG8_SB(1, 1), cB + hstep + kstep, voffB);
        PG8_WAIT_V(6); PG8_BAR;
    } else {
        PG8_STAGE(PG8_SB(0, 0), cB, voffB); PG8_STAGE(PG8_SA(0, 0), cA, voffA); PG8_STAGE(PG8_SB(0, 1), cB + hstep, voffB); PG8_STAGE(PG8_SA(0, 1), cA + hstep, voffA);
        if (wr == 1) PG8_BAR;
        PG8_WAIT_V(4); PG8_BAR;
        PG8_STAGE(PG8_SB(1, 0), cB + kstep, voffB); PG8_STAGE(PG8_SA(1, 0), cA + kstep, voffA); PG8_STAGE(PG8_SB(1, 1), cB + hstep + kstep, voffB);
        PG8_WAIT_V(6); PG8_BAR;
    }
    for (;;) {
        const bool has_next = S.next(ui + 1, nxt);
        const char* nA = has_next ? (const char*)g.A + (size_t)nxt.pm * tstep : cA; const char* nB = has_next ? (const char*)g.Bt + (size_t)nxt.pn * tstep : cB;
        for (int t = 0; t < nt; t += 2) {
            const bool last = (t == nt - 2);
            const char* a1 = cA + (size_t)(t + 1) * kstep;
            const char* a2 = last ? nA : cA + (size_t)(t + 2) * kstep; const char* b2 = last ? nB : cB + (size_t)(t + 2) * kstep;
            const char* a3 = a2 + kstep; const char* b3 = b2 + kstep;
            if (last && has_next) S.a_ready(nxt);
            if constexpr (SP2) {
            PG8_LDB(B0, 0, 0); PG8_LDB(B1, 0, 1); PG8_SCHED; PG8_LDA(At, 0, 0); PG8_STAGE(PG8_SA(1, 1), a1 + hstep, voffA);
            PG8_WAIT_V(8); PG8_WAIT_L(0); PG8_BAR; PG8_MMA(0, 0, At, B0); PG8_MMA(0, 1, At, B1); PG8_BAR; PG8_SCHED;
            PG8_LDA(At, 0, 1); PG8_STAGE(PG8_SB(0, 0), b2, voffB); PG8_STAGE(PG8_SB(0, 1), b2 + hstep, voffB); PG8_STAGE(PG8_SA(0, 0), a2, voffA);
            PG8_WAIT_V(8); PG8_WAIT_L(0); PG8_BAR; PG8_MMA(1, 0, At, B0); PG8_MMA(1, 1, At, B1); PG8_BAR; PG8_SCHED;
            PG8_LDB(B0, 1, 0); PG8_LDB(B1, 1, 1); PG8_SCHED; PG8_LDA(At, 1, 0); PG8_STAGE(PG8_SA(0, 1), a2 + hstep, voffA);
            PG8_WAIT_V(8); PG8_WAIT_L(0); PG8_BAR; PG8_MMA(0, 0, At, B0); PG8_MMA(0, 1, At, B1); PG8_BAR; PG8_SCHED;
            PG8_LDA(At, 1, 1); PG8_STAGE(PG8_SB(1, 0), b3, voffB); PG8_STAGE(PG8_SB(1, 1), b3 + hstep, voffB); PG8_STAGE(PG8_SA(1, 0), a3, voffA);
            PG8_WAIT_V(8); PG8_WAIT_L(0); PG8_BAR; PG8_MMA(1, 0, At, B0); PG8_MMA(1, 1, At, B1); PG8_BAR; PG8_SCHED;
            } else {
            PG8_LDB(B0, 0, 0); PG8_SCHED; PG8_LDA(At, 0, 0); PG8_STAGE(PG8_SA(1, 1), a1 + hstep, voffA);
            PG8_WAIT_L(8); PG8_BAR; PG8_WAIT_L(0); PG8_MMA(0, 0, At, B0); PG8_BAR; PG8_SCHED;
            PG8_LDB(B1, 0, 1); PG8_STAGE(PG8_SB(0, 0), b2, voffB);
            PG8_BAR; PG8_WAIT_L(0); PG8_MMA(0, 1, At, B1); PG8_BAR;
            PG8_LDA(At, 0, 1); PG8_STAGE(PG8_SA(0, 0), a2, voffA);
            PG8_BAR; PG8_WAIT_L(0); PG8_MMA(1, 0, At, B0); PG8_BAR; PG8_SCHED;
            PG8_STAGE(PG8_SB(0, 1), b2 + hstep, voffB);
            PG8_WAIT_V(6); PG8_BAR; PG8_MMA(1, 1, At, B1); PG8_BAR;
            PG8_LDB(B0, 1, 0); PG8_SCHED; PG8_LDA(At, 1, 0); PG8_STAGE(PG8_SA(0, 1), a2 + hstep, voffA);
            PG8_WAIT_L(8); PG8_BAR; PG8_WAIT_L(0); PG8_MMA(0, 0, At, B0); PG8_BAR; PG8_SCHED;
            PG8_LDB(B1, 1, 1); PG8_STAGE(PG8_SB(1, 0), b3, voffB);
            PG8_BAR; PG8_WAIT_L(0); PG8_MMA(0, 1, At, B1); PG8_BAR;
            PG8_LDA(At, 1, 1); PG8_STAGE(PG8_SA(1, 0), a3, voffA);
            PG8_BAR; PG8_WAIT_L(0); PG8_MMA(1, 0, At, B0); PG8_BAR; PG8_SCHED;
            PG8_STAGE(PG8_SB(1, 1), b3 + hstep, voffB);
            PG8_WAIT_V(6); PG8_BAR; PG8_MMA(1, 1, At, B1); PG8_BAR;
            }
        }
        if constexpr (ALIGN_EPI) { if (wr == 0) PG8_BAR; }
        if constexpr (!Epi::AFTER_DRAIN) { E(acc, cur, wr, wc, fr, fq); S.done(cur); }
        if (!has_next) break;
#pragma unroll
        for (int a = 0; a < 2; ++a)
#pragma unroll
            for (int b = 0; b < 2; ++b)
#pragma unroll
                for (int m = 0; m < 4; ++m)
#pragma unroll
                    for (int n = 0; n < 2; ++n) acc[a][b][m][n] = (f32x4){0.f, 0.f, 0.f, 0.f};
        cur = nxt; cA = nA; cB = nB; ++ui;
        if constexpr (ALIGN_EPI) { if (wr == 1) PG8_BAR; }
    }
    PG8_WAIT_V(0);
    if constexpr (!ALIGN_EPI) { if (wr == 0) PG8_BAR; }
    PG8_BAR;
    if constexpr (Epi::AFTER_DRAIN) { E.fused(acc, cur, wr, wc, fr, fq, lds, wid, lane); S.done(cur); }
#undef PG8_SA
#undef PG8_SB
#undef PG8_STAGE
#undef PG8_LDA
#undef PG8_LDB
#undef PG8_MMA
#undef PG8_WAIT_V
#undef PG8_WAIT_L
#undef PG8_BAR
#undef PG8_SCHED
}
}

#ifndef PG8_SP2
#define PG8_SP2 true
#endif
#ifndef PG8_ALIGN
#define PG8_ALIGN true
#endif

__device__ __forceinline__ unsigned cvt_pk_bf16(float lo, float hi) { unsigned r; asm volatile("v_cvt_pk_bf16_f32 %0, %1, %2" : "=v"(r) : "v"(lo), "v"(hi)); return r; }


__device__ __forceinline__ void row_rstd(const float* stats, int row0, int fq, float (&rstd)[2][4]) {
#pragma unroll
    for (int ai = 0; ai < 2; ++ai) {
        f32x4 p[4];
#pragma unroll
        for (int m = 0; m < 4; ++m) p[m] = *(const f32x4*)(stats + (size_t)(row0 + 128 * ai + 16 * m) * 16 + 4 * fq);
#pragma unroll
        for (int m = 0; m < 4; ++m) { float s = (p[m].x + p[m].y) + (p[m].z + p[m].w); s += __shfl_xor(s, 16); s += __shfl_xor(s, 32);
            rstd[ai][m] = 1.0f / sqrtf(s * (1.f / D) + RMS_EPS); }
        asm volatile("" ::: "memory");
    }
}

template <int L> struct EpiQKV {
    static constexpr bool PERM = true, AFTER_DRAIN = false;
    bf16_t *Q, *K, *V; const float *gq, *gk, *rope, *stats, *bias;
    __device__ __forceinline__ void operator()(const f32x4 (&acc)[2][2][4][2], const pg8::Unit& u, int wr, int wc, int fr, int fq) const {
        constexpr int kind = kind_of(L), kvw = kvw_of(L), nkvh = kvw / 64; constexpr bool last = (L == DEPTH - 1);
        const int hh = 4 * u.pn + wc;
        const int type = hh < 16 ? 0 : (hh < 16 + nkvh ? 1 : 2);
        const int hidx = type == 0 ? hh : (type == 1 ? hh - 16 : hh - 16 - nkvh);
        if (last && u.pm >= 64 && type == 0) return;
        const float* gg = type == 0 ? gq : gk;
        f32x4 g4[2][2], b4[2][2];
        const int ci = u.pm < 64 ? (u.pm >> 4) : 4;
        const float* bp = bias + (size_t)ci * nqkv_of(L) + 256 * u.pn + 32 * wc + 8 * fq;
#pragma unroll
        for (int bj = 0; bj < 2; ++bj)
#pragma unroll
            for (int n = 0; n < 2; ++n) { g4[bj][n] = *(const f32x4*)(gg + 32 * bj + 8 * fq + 4 * n); b4[bj][n] = *(const f32x4*)(bp + 128 * bj + 4 * n); }
        float rstd[2][4];
        row_rstd(stats, 256 * u.pm + 64 * wr + fr, fq, rstd);
#pragma unroll
        for (int ai = 0; ai < 2; ++ai)
#pragma unroll
            for (int m = 0; m < 4; ++m) {
                const int row = 256 * u.pm + 128 * ai + 64 * wr + 16 * m + fr;
                f32x4 v[2][2];
#pragma unroll
                for (int bj = 0; bj < 2; ++bj)
#pragma unroll
                    for (int n = 0; n < 2; ++n) v[bj][n] = acc[ai][bj][m][n] * rstd[ai][m] + b4[bj][n];
                if (type < 2) {
                    float ss = 0.f;
#pragma unroll
                    for (int bj = 0; bj < 2; ++bj)
#pragma unroll
                        for (int n = 0; n < 2; ++n) ss += (v[bj][n].x * v[bj][n].x + v[bj][n].y * v[bj][n].y) + (v[bj][n].z * v[bj][n].z + v[bj][n].w * v[bj][n].w);
                    ss += __shfl_xor(ss, 16); ss += __shfl_xor(ss, 32);
                    const float rinv = 1.0f / sqrtf(ss * (1.f / 64.f) + RMS_EPS);
#pragma unroll
                    for (int bj = 0; bj < 2; ++bj)
#pragma unroll
                        for (int n = 0; n < 2; ++n) v[bj][n] = (v[bj][n] * rinv) * g4[bj][n];
                    if (kind != 0 && u.pm < 64) {
                        const int t = row & 4095, pos = fq < 2 ? (t >> 6) : (t & 63);
#pragma unroll
                        for (int n = 0; n < 2; ++n) {
                            const float* tb = rope + (pos * 16 + 8 * (fq & 1) + 4 * n) * 2;
                            const f32x4 t0 = *(const f32x4*)tb, t1 = *(const f32x4*)(tb + 4);
                            const f32x4 cs = (f32x4){t0.x, t0.z, t1.x, t1.z}, sn = (f32x4){t0.y, t0.w, t1.y, t1.w};
                            const f32x4 x1 = v[0][n], x2 = v[1][n];
                            v[0][n] = x1 * cs - x2 * sn; v[1][n] = x2 * cs + x1 * sn;
                        }
                    }
                    if (type == 0) {
#pragma unroll
                        for (int bj = 0; bj < 2; ++bj)
#pragma unroll
                            for (int n = 0; n < 2; ++n) v[bj][n] = v[bj][n] * C2;
                    }
                }
                bf16_t* dst;
                if (type == 0) dst = Q + (size_t)row * D + hidx * 64;
                else dst = (type == 1 ? K : V) + kv_row(row) * kvw + hidx * 64;
#pragma unroll
                for (int bj = 0; bj < 2; ++bj) { u32x4 w; w.x = cvt_pk_bf16(v[bj][0].x, v[bj][0].y); w.y = cvt_pk_bf16(v[bj][0].z, v[bj][0].w); w.z = cvt_pk_bf16(v[bj][1].x, v[bj][1].y); w.w = cvt_pk_bf16(v[bj][1].z, v[bj][1].w);
                    *(u32x4*)(dst + 32 * bj + 8 * fq) = w; }
            }
    }
};

struct EpiResid {
    static constexpr bool PERM = true, AFTER_DRAIN = false;
    float* lat; float* ctx; const float* gate_l;
    bf16_t* H; float* stats; const float* gn; const float* scn;
    __device__ __forceinline__ void operator()(const f32x4 (&acc)[2][2][4][2], const pg8::Unit& u, int wr, int wc, int fr, int fq) const {
        const int ci = u.pm < 64 ? (u.pm >> 4) : 4;
        const int lcol = 32 * wc + 8 * fq;
        const int loff = (64 * wr + fr) * D + lcol;
        const float* gate = gate_l + (size_t)ci * 6144 + 256 * u.pn;
        float* xbu = (u.pm < 64 ? lat + (size_t)(256 * u.pm) * D : ctx + (size_t)(256 * (u.pm - 64)) * D) + 256 * u.pn;
        bf16_t* hbu = H + (size_t)(256 * u.pm) * D + 256 * u.pn;
        const bool emit = gn != nullptr;
        const float* gnu = gn + 256 * u.pn; const float* scu = scn + (size_t)ci * 6144 + 256 * u.pn;
        float ss[2][4];
#pragma unroll
        for (int ai = 0; ai < 2; ++ai)
#pragma unroll
            for (int m = 0; m < 4; ++m) ss[ai][m] = 0.f;
#pragma unroll
        for (int bj = 0; bj < 2; ++bj) {
            f32x4 g4[2], G4[2];
#pragma unroll
            for (int n = 0; n < 2; ++n) { g4[n] = *(const f32x4*)((gate + 128 * bj + 4 * n) + lcol);
                if (emit) G4[n] = *(const f32x4*)((gnu + 128 * bj + 4 * n) + lcol) * (*(const f32x4*)((scu + 128 * bj + 4 * n) + lcol) + 1.0f);
                else G4[n] = (f32x4){0.f, 0.f, 0.f, 0.f}; }
#pragma unroll
            for (int ai = 0; ai < 2; ++ai) {
                f32x4 xl[4][2];
#pragma unroll
                for (int m = 0; m < 4; ++m)
#pragma unroll
                    for (int n = 0; n < 2; ++n) xl[m][n] = *(const f32x4*)((xbu + (128 * ai + 16 * m) * D + 128 * bj + 4 * n) + loff);
                asm volatile("" ::: "memory");
#pragma unroll
                for (int m = 0; m < 4; ++m) { f32x4 xn[2];
#pragma unroll
                    for (int n = 0; n < 2; ++n) { xn[n] = xl[m][n] + g4[n] * acc[ai][bj][m][n]; *(f32x4*)((xbu + (128 * ai + 16 * m) * D + 128 * bj + 4 * n) + loff) = xn[n];
                        ss[ai][m] += (xn[n].x * xn[n].x + xn[n].y * xn[n].y) + (xn[n].z * xn[n].z + xn[n].w * xn[n].w); }
                    if (emit) { const f32x4 h0 = xn[0] * G4[0], h1 = xn[1] * G4[1];
                        u32x4 w; w.x = cvt_pk_bf16(h0.x, h0.y); w.y = cvt_pk_bf16(h0.z, h0.w); w.z = cvt_pk_bf16(h1.x, h1.y); w.w = cvt_pk_bf16(h1.z, h1.w);
                        *(u32x4*)((hbu + (128 * ai + 16 * m) * D + 128 * bj) + loff) = w; } }
                asm volatile("" ::: "memory");
            }
        }
        if (emit) {
            float* stu = stats + (size_t)(256 * u.pm) * 16 + 4 * u.pn + wc;
#pragma unroll
            for (int ai = 0; ai < 2; ++ai)
#pragma unroll
                for (int m = 0; m < 4; ++m) { float t = ss[ai][m]; t += __shfl_xor(t, 16); t += __shfl_xor(t, 32);
                    if (fq == 0) (stu + (128 * ai + 16 * m) * 16)[(64 * wr + fr) * 16] = t; }
        }
    }
};

struct EpiStore {
    static constexpr bool PERM = true, AFTER_DRAIN = false;
    bf16_t* O; int ldc;
    __device__ __forceinline__ void operator()(const f32x4 (&acc)[2][2][4][2], const pg8::Unit& u, int wr, int wc, int fr, int fq) const {
        bf16_t* base = O + (size_t)(256 * u.pm + 64 * wr + fr) * ldc + 256 * u.pn + 32 * wc + 8 * fq;
#pragma unroll
        for (int ai = 0; ai < 2; ++ai)
#pragma unroll
            for (int m = 0; m < 4; ++m) { bf16_t* rowp = base + (size_t)(128 * ai + 16 * m) * ldc;
#pragma unroll
                for (int bj = 0; bj < 2; ++bj) { const f32x4 v0 = acc[ai][bj][m][0], v1 = acc[ai][bj][m][1];
                    u32x4 w; w.x = cvt_pk_bf16(v0.x, v0.y); w.y = cvt_pk_bf16(v0.z, v0.w); w.z = cvt_pk_bf16(v1.x, v1.y); w.w = cvt_pk_bf16(v1.z, v1.w);
                    *(u32x4*)(rowp + 128 * bj) = w; } }
    }
};


__device__ __forceinline__ float dpp_up(float cur, float prevblk) {
    const int old = __builtin_amdgcn_update_dpp(0, __builtin_bit_cast(int, prevblk), 0x121  , 0xf, 0xf, true);
    return __builtin_bit_cast(float, __builtin_amdgcn_update_dpp(old, __builtin_bit_cast(int, cur), 0x111  , 0xf, 0xf, false));
}
__device__ __forceinline__ float dpp_dn(float cur, float nextblk) {
    const int old = __builtin_amdgcn_update_dpp(0, __builtin_bit_cast(int, nextblk), 0x12F  , 0xf, 0xf, true);
    return __builtin_bit_cast(float, __builtin_amdgcn_update_dpp(old, __builtin_bit_cast(int, cur), 0x101  , 0xf, 0xf, false));
}
struct EpiUpConv {
    static constexpr bool PERM = true, AFTER_DRAIN = false;
    bf16_t* ACT; float* HB; const float* cw; const float* cb;
    const float* stats; const float* bias;
    __device__ __forceinline__ void operator()(f32x4 (&acc)[2][2][4][2], const pg8::Unit& u, int wr, int wc, int fr, int fq) const {
        const int ca = 128 * u.pn + 32 * wc + 8 * fq;
        { const int ci = u.pm < 64 ? (u.pm >> 4) : 4;
          const float* bp = bias + (size_t)ci * NUP + 256 * u.pn + 32 * wc + 8 * fq;
          float rstd[2][4];
          row_rstd(stats, 256 * u.pm + 64 * wr + fr, fq, rstd);
#pragma unroll
          for (int bj = 0; bj < 2; ++bj)
#pragma unroll
              for (int n = 0; n < 2; ++n) { const f32x4 b4 = *(const f32x4*)(bp + 128 * bj + 4 * n);
#pragma unroll
                  for (int ai = 0; ai < 2; ++ai)
#pragma unroll
                      for (int m = 0; m < 4; ++m) acc[ai][bj][m][n] = acc[ai][bj][m][n] * rstd[ai][m] + b4; } }
        unsigned outp[2][4][2][2];
#pragma unroll
        for (int n = 0; n < 2; ++n) {
            f32x4 wa[3], wg[3];
#pragma unroll
            for (int tap = 0; tap < 3; ++tap) { wa[tap] = *(const f32x4*)(cw + tap * NUP + ca + 4 * n); wg[tap] = *(const f32x4*)(cw + tap * NUP + DFF + ca + 4 * n); }
            const f32x4 ba = *(const f32x4*)(cb + ca + 4 * n), bg = *(const f32x4*)(cb + DFF + ca + 4 * n);
#pragma unroll
            for (int ai = 0; ai < 2; ++ai)
#pragma unroll
                for (int m = 0; m < 4; ++m) {
                    const f32x4 z = (f32x4){0.f, 0.f, 0.f, 0.f};
                    const f32x4 A = acc[ai][0][m][n], G = acc[ai][1][m][n];
                    const f32x4 Ap = m > 0 ? acc[ai][0][m - 1][n] : z, An = m < 3 ? acc[ai][0][m + 1][n] : z;
                    const f32x4 Gp = m > 0 ? acc[ai][1][m - 1][n] : z, Gn = m < 3 ? acc[ai][1][m + 1][n] : z;
                    float r[4];
#pragma unroll
                    for (int i = 0; i < 4; ++i) {
                        const float av = ba[i] + wa[0][i] * dpp_up(A[i], Ap[i]) + wa[1][i] * A[i] + wa[2][i] * dpp_dn(A[i], An[i]);
                        const float gv = bg[i] + wg[0][i] * dpp_up(G[i], Gp[i]) + wg[1][i] * G[i] + wg[2][i] * dpp_dn(G[i], Gn[i]);
                        r[i] = av * gv * __builtin_amdgcn_rcpf(1.0f + __builtin_amdgcn_exp2f(-LOG2E * gv));
                    }
                    outp[ai][m][n][0] = cvt_pk_bf16(r[0], r[1]); outp[ai][m][n][1] = cvt_pk_bf16(r[2], r[3]);
                }
        }
        const int row0 = 256 * u.pm + 64 * wr + fr;
#pragma unroll
        for (int ai = 0; ai < 2; ++ai)
#pragma unroll
            for (int m = 0; m < 4; ++m) { u32x4 w; w.x = outp[ai][m][0][0]; w.y = outp[ai][m][0][1]; w.z = outp[ai][m][1][0]; w.w = outp[ai][m][1][1];
                *(u32x4*)(ACT + (size_t)(row0 + 128 * ai + 16 * m) * DFF + ca) = w; }
        const int pc = 256 * u.pn + 32 * wc + 8 * fq;
#pragma unroll
        for (int ai = 0; ai < 2; ++ai) {
            const int grp = 4 * u.pm + 2 * ai + wr;
            if (fr < 2) { float* hb = HB + ((size_t)grp * 4 + fr) * NUP + pc;
#pragma unroll
                for (int bj = 0; bj < 2; ++bj)
#pragma unroll
                    for (int n = 0; n < 2; ++n) *(f32x4*)(hb + 128 * bj + 4 * n) = acc[ai][bj][0][n]; }
            if (fr >= 14) { float* hb = HB + ((size_t)grp * 4 + 2 + (fr - 14)) * NUP + pc;
#pragma unroll
                for (int bj = 0; bj < 2; ++bj)
#pragma unroll
                    for (int n = 0; n < 2; ++n) *(f32x4*)(hb + 128 * bj + 4 * n) = acc[ai][bj][3][n]; }
        }
    }
};
__device__ __forceinline__ void ph_upconv_fast(const Params& P, int l, LAS unsigned char* lds, int nrows) {
    pg8::Gemm g{(const bf16_t*)(P.ws + WS_H), wt_up(P, l), nrows, NUP, D};
    pg8::StaticOrder S; S.init(nrows, NUP, (int)gridDim.x, (int)blockIdx.x);
    EpiUpConv E{(bf16_t*)(P.ws + WS_ACT), (float*)(P.ws + WS_HB), P.in[23] + (size_t)l * 3 * NUP, P.in[24] + (size_t)l * NUP, (const float*)(P.ws + WS_STATS), (const float*)(P.ws + WS_BUP) + (size_t)l * 5 * NUP};
    pg8::gemm_phase<EpiUpConv, pg8::StaticOrder, PG8_ALIGN, PG8_SP2>(lds, g, S, E);
}
__device__ __forceinline__ void ph_fix(const Params& P, int l, int nrows) {
    const int gt = blockIdx.x * NTHREADS + tid_opaque(), NGT = gridDim.x * NTHREADS;
    const float* HB = (const float*)(P.ws + WS_HB); bf16_t* ACT = (bf16_t*)(P.ws + WS_ACT);
    const float* cw = P.in[23] + (size_t)l * 3 * NUP; const float* cb = P.in[24] + (size_t)l * NUP;
    const int per_row = DFF / 4, nitems = (nrows / 64) * 2 * per_row;
    for (int it = gt; it < nitems; it += NGT) {
        const int c = (it % per_row) * 4, ge = it / per_row, grp = ge >> 1, e = ge & 1;
        const int row = 64 * grp + (e ? 63 : 0);
        const int pos = row < MLAT ? (row & 4095) : ((row - MLAT) & 255), slen = row < MLAT ? SEQ : CTX;
        const int pa = 256 * (c >> 7) + (c & 127);
        const float* ctr = HB + ((size_t)grp * 4 + (e ? 3 : 0)) * NUP + pa;
        const float* upp = e ? HB + ((size_t)grp * 4 + 2) * NUP + pa : (pos > 0 ? HB + ((size_t)(grp - 1) * 4 + 3) * NUP + pa : nullptr);
        const float* dnp = e ? (pos < slen - 1 ? HB + ((size_t)(grp + 1) * 4 + 0) * NUP + pa : nullptr) : HB + ((size_t)grp * 4 + 1) * NUP + pa;
        f32x4 av = *(const f32x4*)(cb + c), gv = *(const f32x4*)(cb + DFF + c);
        av = av + *(const f32x4*)(cw + NUP + c) * *(const f32x4*)ctr; gv = gv + *(const f32x4*)(cw + NUP + DFF + c) * *(const f32x4*)(ctr + 128);
        if (upp) { av = av + *(const f32x4*)(cw + c) * *(const f32x4*)upp; gv = gv + *(const f32x4*)(cw + DFF + c) * *(const f32x4*)(upp + 128); }
        if (dnp) { av = av + *(const f32x4*)(cw + 2 * NUP + c) * *(const f32x4*)dnp; gv = gv + *(const f32x4*)(cw + 2 * NUP + DFF + c) * *(const f32x4*)(dnp + 128); }
        u32x2 o; o.x = pk2(av.x * silu_f(gv.x), av.y * silu_f(gv.y)); o.y = pk2(av.z * silu_f(gv.z), av.w * silu_f(gv.w));
        *(u32x2*)(ACT + (size_t)row * DFF + c) = o;
    }
}

template <int L> __device__ __forceinline__ void ph_qkv_fast(const Params& P, LAS unsigned char* lds) {
    const LayerW lw = layer_w(P, L);
    pg8::Gemm g{(const bf16_t*)(P.ws + WS_H), wt_qkv(P, L), MTOT, nqkv_of(L), D};
    pg8::StaticOrder S; S.init(MTOT, nqkv_of(L), (int)gridDim.x, (int)blockIdx.x);
    EpiQKV<L> E{(bf16_t*)(P.ws + WS_Q), (bf16_t*)(P.ws + WS_K), (bf16_t*)(P.ws + WS_V), lw.gq, lw.gk, (const float*)(P.ws + WS_ROPE), (const float*)(P.ws + WS_STATS), (const float*)(P.ws + WS_BQKV) + (size_t)L * 5 * 3072};
    pg8::gemm_phase<EpiQKV<L>, pg8::StaticOrder, PG8_ALIGN, PG8_SP2>(lds, g, S, E);
}
__device__ __forceinline__ void ph_resid_fast(const Params& P, int l, LAS unsigned char* lds, const bf16_t* A, int K, const bf16_t* W, int gate_off, int nrows, const float* gn, const float* scn, bool dummy = false) {
    pg8::Gemm g{A, W, nrows, D, K};
    pg8::StaticOrder S; S.init(nrows, D, (int)gridDim.x, (int)blockIdx.x);
    EpiResid E{dummy ? (float*)(P.ws + WS_K) : P.out, dummy ? (float*)(P.ws + WS_O) : (float*)(P.ws + WS_CTXRES), mod_ptr(P, l, 0) + gate_off, dummy ? (bf16_t*)(P.ws + WS_Q) : (bf16_t*)(P.ws + WS_H), dummy ? (float*)(P.ws + WS_O + 8 * MiB) : (float*)(P.ws + WS_STATS), gn, scn};
    pg8::gemm_phase<EpiResid, pg8::StaticOrder, PG8_ALIGN, PG8_SP2>(lds, g, S, E);
}
__device__ __forceinline__ void ph_up_fast(const Params& P, int l, LAS unsigned char* lds, int r0, int nrows) {
    pg8::Gemm g{(const bf16_t*)(P.ws + WS_H) + (size_t)r0 * D, wt_up(P, l), nrows, NUP, D};
    pg8::StaticOrder S; S.init(nrows, NUP, (int)gridDim.x, (int)blockIdx.x);
    EpiStore E{(bf16_t*)(P.ws + WS_U), NUP};
    pg8::gemm_phase<EpiStore, pg8::StaticOrder, PG8_ALIGN, PG8_SP2>(lds, g, S, E);
}

namespace att {
using s16x4 = __attribute__((ext_vector_type(4))) short;
using f32x16 = __attribute__((ext_vector_type(16))) float;
constexpr int NW = 8, QBLK = 32, QB = QBLK * NW, KVBLK = 64;
constexpr int NSLOT = 3, SLOTB = 8192;
constexpr int LDS_K = 0, LDS_V = NSLOT * SLOTB, LDS_WS = 2 * NSLOT * SLOTB, LDS_OST = LDS_WS + NW * 64 * 4, LDS_BIAS = LDS_OST + NW * 4096, LDS_BYTES = LDS_BIAS + 2048;
#define SBAR() __builtin_amdgcn_sched_barrier(0)
__device__ __forceinline__ int crow(int r, int hi) { return (r & 3) + 8 * (r >> 2) + 4 * hi; }
__device__ __forceinline__ void glds16(const void* gsrc, unsigned lds_dst) { unsigned keep;
    asm volatile("s_mov_b32 %0, m0\n\ts_mov_b32 m0, %2\n\ts_nop 0\n\tglobal_load_lds_dwordx4 %1, off\n\ts_mov_b32 m0, %0" : "=&s"(keep) : "v"(gsrc), "s"(lds_dst) : "memory"); }
__device__ __forceinline__ float max3f(float a, float b, float c) { float r; asm("v_max3_f32 %0, %1, %2, %3" : "=v"(r) : "v"(a), "v"(b), "v"(c)); return r; }
__device__ __forceinline__ float max2f(float a, float b) { float r; asm("v_max_f32_e32 %0, %1, %2" : "=v"(r) : "v"(a), "v"(b)); return r; }
__device__ __forceinline__ float fadd_s(float a, float b) { float r; asm("v_add_f32_e32 %0, %1, %2" : "=v"(r) : "v"(a), "v"(b)); return r; }
__device__ __forceinline__ float fsub_s(float a, float b) { float r; asm("v_sub_f32_e32 %0, %1, %2" : "=v"(r) : "v"(a), "v"(b)); return r; }
typedef float f32x2_t __attribute__((ext_vector_type(2))); typedef __bf16 bf16x2_t __attribute__((ext_vector_type(2)));
__device__ __forceinline__ unsigned cvtpk_s(float lo, float hi) { f32x2_t v = {lo, hi}; bf16x2_t b = __builtin_convertvector(v, bf16x2_t); return __builtin_bit_cast(unsigned, b); }
#define WAIT_BAR(N) asm volatile("s_waitcnt vmcnt(" #N ") lgkmcnt(0)\n\ts_barrier" ::: "memory")

__device__ __forceinline__ void qkt(f32x16& p0, f32x16& p1, const char* Kslot, const bf16x8* qr, const f32x16& negm, int r32, int hi) {
    const char* kb = Kslot + hi * 1024 + r32 * 16;
#pragma unroll
    for (int d0 = 0; d0 < 4; ++d0) {
        const bf16x8 b0 = *reinterpret_cast<const bf16x8*>(kb + d0 * 2048);
        const bf16x8 b1 = *reinterpret_cast<const bf16x8*>(kb + d0 * 2048 + 512);
        if (d0 == 0) { p0 = __builtin_amdgcn_mfma_f32_32x32x16_bf16(b0, qr[0], negm, 0, 0, 0); p1 = __builtin_amdgcn_mfma_f32_32x32x16_bf16(b1, qr[0], negm, 0, 0, 0); }
        else { p0 = __builtin_amdgcn_mfma_f32_32x32x16_bf16(b0, qr[d0], p0, 0, 0, 0); p1 = __builtin_amdgcn_mfma_f32_32x32x16_bf16(b1, qr[d0], p1, 0, 0, 0); } }
}
typedef __attribute__((address_space(3))) const char* lds_cptr;
typedef short v4i16_t __attribute__((ext_vector_type(4)));
__device__ __forceinline__ void kload8(bf16x8* kf, lds_cptr kp) {
    kf[0] = *(const __attribute__((address_space(3))) bf16x8*)(kp);        kf[1] = *(const __attribute__((address_space(3))) bf16x8*)(kp + 512);
    kf[2] = *(const __attribute__((address_space(3))) bf16x8*)(kp + 2048); kf[3] = *(const __attribute__((address_space(3))) bf16x8*)(kp + 2560);
    kf[4] = *(const __attribute__((address_space(3))) bf16x8*)(kp + 4096); kf[5] = *(const __attribute__((address_space(3))) bf16x8*)(kp + 4608);
    kf[6] = *(const __attribute__((address_space(3))) bf16x8*)(kp + 6144); kf[7] = *(const __attribute__((address_space(3))) bf16x8*)(kp + 6656);
}
__device__ __forceinline__ void kload2(bf16x8* kf, lds_cptr kp, int j) { kf[2 * j] = *(const __attribute__((address_space(3))) bf16x8*)(kp + j * 2048); kf[2 * j + 1] = *(const __attribute__((address_space(3))) bf16x8*)(kp + j * 2048 + 512); }
__device__ __forceinline__ s16x4 vtr(lds_cptr p) { return __builtin_bit_cast(s16x4, __builtin_amdgcn_ds_read_tr16_b64_v4i16((__attribute__((address_space(3))) v4i16_t*)p)); }
__device__ __forceinline__ float rowmax(const f32x16& p0, const f32x16& p1) {
    float a = max3f(p0[0], p0[1], p1[0]), b = max3f(p0[2], p0[3], p1[1]); a = max3f(a, p1[2], p1[3]);
#pragma unroll
    for (int r = 4; r < 16; r += 4) { a = max3f(a, p0[r], p0[r + 1]); b = max3f(b, p0[r + 2], p0[r + 3]); a = max3f(a, p1[r], p1[r + 1]); b = max3f(b, p1[r + 2], p1[r + 3]); }
    const float m = max2f(a, b);
    auto rr = __builtin_amdgcn_permlane32_swap(__float_as_uint(m), __float_as_uint(m), false, false);
    return max2f(__uint_as_float(rr[0]), __uint_as_float(rr[1]));
}
__device__ __forceinline__ void pv(f32x16* o, int vb, bf16x8 pa0, bf16x8 pa1, bf16x8 pa2, bf16x8 pa3) {
#pragma unroll
    for (int d0 = 0; d0 < 2; ++d0) { s16x4 lo[4], hi[4];
#pragma unroll
        for (int ks = 0; ks < 4; ++ks) {
            asm volatile("ds_read_b64_tr_b16 %0,%1 offset:%c2" : "=&v"(lo[ks]) : "v"(vb), "i"(d0 * 4096 + ks * 1024) : "memory");
            asm volatile("ds_read_b64_tr_b16 %0,%1 offset:%c2" : "=&v"(hi[ks]) : "v"(vb), "i"(d0 * 4096 + ks * 1024 + 512) : "memory"); }
        asm volatile("s_waitcnt lgkmcnt(0)" ::: "memory"); SBAR();
#define PK(k) (bf16x8){lo[k][0], lo[k][1], lo[k][2], lo[k][3], hi[k][0], hi[k][1], hi[k][2], hi[k][3]}
        o[d0] = __builtin_amdgcn_mfma_f32_32x32x16_bf16(pa0, PK(0), o[d0], 0, 0, 0);
        o[d0] = __builtin_amdgcn_mfma_f32_32x32x16_bf16(pa1, PK(1), o[d0], 0, 0, 0);
        o[d0] = __builtin_amdgcn_mfma_f32_32x32x16_bf16(pa2, PK(2), o[d0], 0, 0, 0);
        o[d0] = __builtin_amdgcn_mfma_f32_32x32x16_bf16(pa3, PK(3), o[d0], 0, 0, 0);
#undef PK
    }
}

struct Unit {
    int qrow0;
    int kvrow0;
    int h, kvh;
    int T0, NL;
    int tq0;
    int has_sink; float sink_l2;
};
struct MaskLane { int swa_base; int rq, rs; int c, cs; };

template <int MODE> __device__ __forceinline__ void amask(f32x16& p0, f32x16& p1, int t, const Unit& u, const MaskLane& ml, int hi, lds_cptr btab) {
    if (MODE == 0) return;
    if (t < 4) return;
    const float NEG = -INFINITY;
    if (MODE == 1) {
        const int d0 = ml.swa_base + 64 * (t - 4);
#pragma unroll
        for (int r = 0; r < 16; ++r) { const int d = d0 + (r & 3) + 8 * (r >> 2); if ((unsigned)d > 256u) p0[r] = NEG; if ((unsigned)(d + 32) > 256u) p1[r] = NEG; }
    } else {
        const int kr = u.T0 + t - 4;
        if (kr < ml.rs || kr >= ml.rs + 8) {
#pragma unroll
            for (int r = 0; r < 16; ++r) { p0[r] = NEG; p1[r] = NEG; }
        } else {
            const __attribute__((address_space(3))) float* brow = (const __attribute__((address_space(3))) float*)btab + (kr - ml.rq + 7) * 31 + (15 - ml.c + 4 * hi);
            const int k0 = 4 * hi - ml.cs;
#pragma unroll
            for (int r = 0; r < 16; ++r) { const int kk = (r & 3) + 8 * (r >> 2);
                const float b0 = brow[kk], b1 = brow[kk + 32];
                p0[r] = ((unsigned)(k0 + kk) < 16u) ? p0[r] + b0 : NEG;
                p1[r] = ((unsigned)(k0 + kk + 32) < 16u) ? p1[r] + b1 : NEG; }
        }
    }
}

template <int MODE, int KVP, int THRL>
__device__ __forceinline__ void attn_unit(const Unit& u, const bf16_t* Q, const bf16_t* __restrict__ K, const bf16_t* __restrict__ V, bf16_t* O, const float* rpb_h, char* shm) {
    const int tid = tid_opaque(), lane = tid & 63, r32 = lane & 31, hi = lane >> 5; const int wid = __builtin_amdgcn_readfirstlane(tid >> 6);
    const bf16_t* Qw = Q + (size_t)(u.qrow0 + wid * QBLK) * D + u.h * 64;
    const bf16_t* Kh = K + (size_t)u.kvrow0 * KVP + u.kvh * 64; const bf16_t* Vh = V + (size_t)u.kvrow0 * KVP + u.kvh * 64;
    const unsigned lds0 = (unsigned)(uintptr_t)shm;
    float* wsf = (float*)(shm + LDS_WS) + wid * 64;
    const bf16_t* ksrc = Kh + (long)lane * KVP + wid * 8;
    const bf16_t* vsrc = Vh + (long)(16 * (wid & 3) + (lane >> 2)) * KVP + (wid >> 2) * 32 + (lane & 3) * 8;
    const unsigned kdst = lds0 + LDS_K + wid * 1024, vdst = lds0 + LDS_V + wid * 1024;
    const int T0 = u.T0;
#define TPOS(t) ((long)(((t) < 4) ? (SEQ + 64 * (t)) : 64 * (T0 + (t) - 4)) * KVP)
#define DMA_K(t, slot) glds16(ksrc + TPOS(t), (unsigned)__builtin_amdgcn_readfirstlane(kdst + (slot)))
#define DMA_V(t, slot) glds16(vsrc + TPOS(t), (unsigned)__builtin_amdgcn_readfirstlane(vdst + (slot)))
    const int vb0 = (int)(lds0 + LDS_V) + ((lane >> 4) & 1) * 32 + (lane & 3) * 8 + (4 * hi + ((lane & 15) >> 2)) * 64;
    const char* Kbase = shm + LDS_K; bf16x8 kf[8];
    const lds_cptr shm3 = (lds_cptr)shm; const lds_cptr kp0 = shm3 + LDS_K + hi * 1024 + r32 * 16; const lds_cptr vp0 = shm3 + LDS_V + ((lane >> 4) & 1) * 32 + (lane & 3) * 8 + (4 * hi + ((lane & 15) >> 2)) * 64;
    const lds_cptr btab = shm3 + LDS_BIAS;
    const int NT = 4 + u.NL;
    DMA_K(0, 0); DMA_V(0, 0); DMA_K(1, SLOTB);
    MaskLane ml; ml.swa_base = 0; ml.rq = 0; ml.rs = 0; ml.c = 0; ml.cs = 0;
    if (MODE == 1) ml.swa_base = 64 * T0 - (u.tq0 + wid * QBLK + r32) + 128 + 4 * hi;
    if (MODE == 2) { ml.rq = (u.tq0 >> 6) + (wid >> 1); int rs = ml.rq - 4; ml.rs = rs < 0 ? 0 : (rs > 56 ? 56 : rs); ml.c = 32 * (wid & 1) + r32; int cs = ml.c - 8; ml.cs = cs < 0 ? 0 : (cs > 48 ? 48 : cs);
        if (tid < 15 * 31) ((float*)(shm + LDS_BIAS))[tid] = rpb_h[tid] * LOG2E; }
    bf16x8 qr[4];
#pragma unroll
    for (int d0 = 0; d0 < 4; ++d0) qr[d0] = *reinterpret_cast<const bf16x8*>(&Qw[(long)r32 * D + d0 * 16 + hi * 8]);
    float mhat = 0.f, l_reg = 0.f; f32x16 o[2]; o[0] = f32x16{}; o[1] = f32x16{}; f32x16 negm = f32x16{}; asm volatile("" : "+v"(negm));
#define CMASK(P0, P1, t) amask<MODE>(P0, P1, (t), u, ml, hi, btab)
    bool resc = false;
#define START(P0, P1) do { const float rm = rowmax(P0, P1); resc = false; \
    { const float dl = rm; mhat = fadd_s(mhat, dl); \
      _Pragma("unroll") for (int r = 0; r < 16; ++r) { P0[r] = fsub_s(P0[r], dl); P1[r] = fsub_s(P1[r], dl); } \
      _Pragma("unroll") for (int r = 0; r < 16; ++r) negm[r] = -mhat; asm volatile("" : "+v"(negm)); } \
    _Pragma("unroll") for (int r = 0; r < 16; ++r) P0[r] = __builtin_amdgcn_exp2f(P0[r]); } while (0)
#define RESC() do { if (resc) { asm volatile("s_waitcnt lgkmcnt(0)" ::: "memory"); \
      _Pragma("unroll") for (int d_ = 0; d_ < 2; ++d_) _Pragma("unroll") for (int r = 0; r < 16; ++r) o[d_][r] *= wsf[crow(r, hi)]; } } while (0)
    f32x16 pA0, pA1, pB0, pB1;
    int sl_prev = 0, sl_cur = 0, sl_next = SLOTB;
#define ROT() do { sl_prev = sl_cur; sl_cur = sl_next; sl_next = (sl_next == (NSLOT - 1) * SLOTB) ? 0 : sl_next + SLOTB; } while (0)
    DMA_K(2, 2 * SLOTB);
    WAIT_BAR(3);
    qkt(pA0, pA1, Kbase, qr, negm, r32, hi); asm volatile("s_nop 15\n\ts_nop 7" : "+v"(pA0), "+v"(pA1));
    START(pA0, pA1);
    _Pragma("unroll") for (int r = 0; r < 16; ++r) pA1[r] = __builtin_amdgcn_exp2f(pA1[r]);
    WAIT_BAR(0);
    DMA_K(3, 0); DMA_V(1, SLOTB);
    ROT();
    kload8(kf, kp0 + sl_cur);
    WAIT_BAR(2);
    s16x4 vlo[8], vhi[8]; u32x4 pw0, pw1, pw2, pw3;
#define PKW(P, B) cvtpk_s(P[B], P[B + 1])
#define PAF(k) __builtin_bit_cast(bf16x8, pw##k)
#define VFR(i) (bf16x8){vlo[i][0], vlo[i][1], vlo[i][2], vlo[i][3], vhi[i][0], vhi[i][1], vhi[i][2], vhi[i][3]}
#define PIN(x) asm volatile("" : "+v"(x))
#define MX3(a, b, c) __builtin_fmaxf(__builtin_fmaxf((a), (b)), (c))
#define GAPA(MF, A0, A1, A2, A3, W0, W1, PW) do { MF; sacc += A0; sacc += A1; sacc += A2; sacc += A3; PIN(sacc); W0; W1; PIN(PW); SBAR(); } while (0)
#define EX(v) __builtin_amdgcn_exp2f(v)
#define GAPB(MF, X, B) do { MF; X[B] = EX(X[B]); X[B + 1] = EX(X[B + 1]); X[B + 2] = EX(X[B + 2]); X[B + 3] = EX(X[B + 3]); PIN(X); SBAR(); } while (0)
#define VRD(i) do { vlo[i] = vtr(vp_ + (((i) >> 2) * 4096 + ((i) & 3) * 1024)); vhi[i] = vtr(vp_ + (((i) >> 2) * 4096 + ((i) & 3) * 1024 + 512)); } while (0)
#define KRD(G, j) do { if (G) { kload2(kf, kp0 + sl_next, j); SBAR(); } } while (0)
#define STEP(C0, C1, P0, P1, t, GK, GV, GL) do { SBAR(); \
    const lds_cptr vp_ = vp0 + sl_prev; \
    VRD(0); SBAR(); float sacc = (P0[0] + P0[1]); \
    GAPA(C0 = __builtin_amdgcn_mfma_f32_32x32x16_bf16(kf[0], qr[0], negm, 0, 0, 0), P0[2], P0[3], P0[4], P0[5],     pw0[0] = PKW(P0, 0), pw0[1] = PKW(P0, 2), pw0); \
    VRD(4); SBAR(); GAPA(C1 = __builtin_amdgcn_mfma_f32_32x32x16_bf16(kf[1], qr[0], negm, 0, 0, 0), P0[6], P0[7], P0[8], P0[9],     pw0[2] = PKW(P0, 4), pw0[3] = PKW(P0, 6), pw0); \
    VRD(1); SBAR(); GAPA(C0 = __builtin_amdgcn_mfma_f32_32x32x16_bf16(kf[2], qr[1], C0, 0, 0, 0),   P0[10], P0[11], P0[12], P0[13], pw1[0] = PKW(P0, 8), pw1[1] = PKW(P0, 10), pw1); \
    VRD(5); SBAR(); GAPA(C1 = __builtin_amdgcn_mfma_f32_32x32x16_bf16(kf[3], qr[1], C1, 0, 0, 0),   P0[14], P0[15], P1[0], P1[1],   pw1[2] = PKW(P0, 12), pw1[3] = PKW(P0, 14), pw1); \
    VRD(2); SBAR(); GAPA(C0 = __builtin_amdgcn_mfma_f32_32x32x16_bf16(kf[4], qr[2], C0, 0, 0, 0),   P1[2], P1[3], P1[4], P1[5],     pw2[0] = PKW(P1, 0), pw2[1] = PKW(P1, 2), pw2); \
    VRD(6); SBAR(); GAPA(C1 = __builtin_amdgcn_mfma_f32_32x32x16_bf16(kf[5], qr[2], C1, 0, 0, 0),   P1[6], P1[7], P1[8], P1[9],     pw2[2] = PKW(P1, 4), pw2[3] = PKW(P1, 6), pw2); \
    VRD(3); SBAR(); GAPA(C0 = __builtin_amdgcn_mfma_f32_32x32x16_bf16(kf[6], qr[3], C0, 0, 0, 0),   P1[10], P1[11], P1[12], P1[13], pw3[0] = PKW(P1, 8), pw3[1] = PKW(P1, 10), pw3); \
    VRD(7); SBAR(); GAPA(C1 = __builtin_amdgcn_mfma_f32_32x32x16_bf16(kf[7], qr[3], C1, 0, 0, 0),   P1[14], P1[15], 0.f, 0.f,       pw3[2] = PKW(P1, 12), pw3[3] = PKW(P1, 14), pw3); \
    l_reg += sacc; \
    if (GK) { DMA_K((t) + 3, sl_cur); } if (GV) { DMA_V((t) + 1, sl_next); } \
    CMASK(C0, C1, t); \
    { float a = MX3(C0[0], C0[1], C1[0]), b = MX3(C0[2], C0[3], C1[1]); a = MX3(a, C1[2], C1[3]); \
      _Pragma("unroll") for (int r = 4; r < 16; r += 4) { a = MX3(a, C0[r], C0[r + 1]); b = MX3(b, C0[r + 2], C0[r + 3]); a = MX3(a, C1[r], C1[r + 1]); b = MX3(b, C1[r + 2], C1[r + 3]); } \
      float rm = __builtin_fmaxf(a, b); { auto rr = __builtin_amdgcn_permlane32_swap(__float_as_uint(rm), __float_as_uint(rm), false, false); rm = __builtin_fmaxf(__uint_as_float(rr[0]), __uint_as_float(rr[1])); } \
      resc = false; \
      if (__builtin_expect(__any(rm > (float)THRL), 0)) { const float dl = __builtin_fmaxf(rm, 0.f); mhat += dl; \
        _Pragma("unroll") for (int r = 0; r < 16; ++r) { C0[r] -= dl; C1[r] -= dl; } \
        _Pragma("unroll") for (int r = 0; r < 16; ++r) negm[r] = -mhat; asm volatile("" : "+v"(negm)); \
        const float f = __builtin_amdgcn_exp2f(-dl); l_reg *= f; if (hi == 0) wsf[r32] = f; resc = true; } } \
    SBAR(); \
    GAPB(o[0] = __builtin_amdgcn_mfma_f32_32x32x16_bf16(PAF(0), VFR(0), o[0], 0, 0, 0), C0, 0); \
    GAPB(o[1] = __builtin_amdgcn_mfma_f32_32x32x16_bf16(PAF(0), VFR(4), o[1], 0, 0, 0), C0, 4); \
    KRD(GL, 0); GAPB(o[0] = __builtin_amdgcn_mfma_f32_32x32x16_bf16(PAF(1), VFR(1), o[0], 0, 0, 0), C0, 8); \
    KRD(GL, 1); GAPB(o[1] = __builtin_amdgcn_mfma_f32_32x32x16_bf16(PAF(1), VFR(5), o[1], 0, 0, 0), C0, 12); \
    KRD(GL, 2); GAPB(o[0] = __builtin_amdgcn_mfma_f32_32x32x16_bf16(PAF(2), VFR(2), o[0], 0, 0, 0), C1, 0); \
    KRD(GL, 3); GAPB(o[1] = __builtin_amdgcn_mfma_f32_32x32x16_bf16(PAF(2), VFR(6), o[1], 0, 0, 0), C1, 4); \
    GAPB(o[0] = __builtin_amdgcn_mfma_f32_32x32x16_bf16(PAF(3), VFR(3), o[0], 0, 0, 0), C1, 8); \
    GAPB(o[1] = __builtin_amdgcn_mfma_f32_32x32x16_bf16(PAF(3), VFR(7), o[1], 0, 0, 0), C1, 12); \
    } while (0)
    int t = 1;
    for (; t + 5 < NT; t += 2) {
        STEP(pB0, pB1, pA0, pA1, t, true, true, true);     WAIT_BAR(2); RESC(); ROT();
        STEP(pA0, pA1, pB0, pB1, t + 1, true, true, true); WAIT_BAR(2); RESC(); ROT();
    }
#define ENDW(tt) do { if ((tt) + 3 < NT) { WAIT_BAR(2); } else if ((tt) + 2 < NT) { WAIT_BAR(1); } else { WAIT_BAR(0); } } while (0)
    for (; t + 1 < NT; t += 2) {
        STEP(pB0, pB1, pA0, pA1, t, (t + 3 < NT), (t + 1 < NT), (t + 1 < NT));         ENDW(t);     RESC(); ROT();
        STEP(pA0, pA1, pB0, pB1, t + 1, (t + 4 < NT), (t + 2 < NT), (t + 2 < NT));     ENDW(t + 1); RESC(); ROT();
    }
    STEP(pB0, pB1, pA0, pA1, NT - 1, false, false, false); RESC();
    { float sacc = pB0[0] + pB0[1]; _Pragma("unroll") for (int r = 2; r < 16; ++r) sacc += pB0[r]; _Pragma("unroll") for (int r = 0; r < 16; ++r) sacc += pB1[r]; l_reg += sacc;
      pw0 = (u32x4){PKW(pB0, 0), PKW(pB0, 2), PKW(pB0, 4), PKW(pB0, 6)}; pw1 = (u32x4){PKW(pB0, 8), PKW(pB0, 10), PKW(pB0, 12), PKW(pB0, 14)}; pw2 = (u32x4){PKW(pB1, 0), PKW(pB1, 2), PKW(pB1, 4), PKW(pB1, 6)}; pw3 = (u32x4){PKW(pB1, 8), PKW(pB1, 10), PKW(pB1, 12), PKW(pB1, 14)};
      SBAR(); pv(o, vb0 + sl_cur, PAF(0), PAF(1), PAF(2), PAF(3)); }
#undef PKW
#undef PAF
#undef VFR
#undef PIN
#undef MX3
#undef GAPA
#undef GAPB
#undef EX
#undef VRD
#undef KRD
#undef STEP
#undef ENDW
    { auto rr = __builtin_amdgcn_permlane32_swap(__float_as_uint(l_reg), __float_as_uint(l_reg), false, false); l_reg = __uint_as_float(rr[0]) + __uint_as_float(rr[1]); }
    if (u.has_sink) l_reg += __builtin_amdgcn_exp2f(u.sink_l2 - mhat);
    if (hi == 0) wsf[32 + r32] = l_reg; asm volatile("s_waitcnt lgkmcnt(0)" ::: "memory");
    float rli[16];
#pragma unroll
    for (int r = 0; r < 16; ++r) rli[r] = __builtin_amdgcn_rcpf(wsf[32 + crow(r, hi)]);
    bf16_t* Ow = O + (size_t)(u.qrow0 + wid * QBLK) * D + u.h * 64;
    { bf16_t* stg = (bf16_t*)(shm + LDS_OST) + wid * 2048;
#pragma unroll
      for (int r = 0; r < 16; ++r) { const int orow = crow(r, hi);
#pragma unroll
          for (int d0 = 0; d0 < 2; ++d0) stg[orow * 64 + d0 * 32 + r32] = (bf16_t)f2bf(o[d0][r] * rli[r]); }
      asm volatile("s_waitcnt lgkmcnt(0)" ::: "memory");
#pragma unroll
      for (int i = 0; i < 4; ++i) { const int row = i * 8 + (lane >> 3), ch = lane & 7; const u32x4 v = *(const u32x4*)(stg + row * 64 + ch * 8); *(u32x4*)(Ow + (long)row * D + ch * 8) = v; } }
    asm volatile("s_waitcnt lgkmcnt(0)\n\ts_barrier" ::: "memory");
#undef DMA_K
#undef DMA_V
#undef TPOS
#undef CMASK
#undef START
#undef RESC
#undef ROT
}

__device__ __forceinline__ void qkt_lds(f32x16& p0, f32x16& p1, lds_cptr kb, const bf16x8* qr) {
    const f32x16 z = f32x16{};
#pragma unroll
    for (int d0 = 0; d0 < 4; ++d0) {
        const bf16x8 b0 = *(const __attribute__((address_space(3))) bf16x8*)(kb + d0 * 2048);
        const bf16x8 b1 = *(const __attribute__((address_space(3))) bf16x8*)(kb + d0 * 2048 + 512);
        if (d0 == 0) { p0 = __builtin_amdgcn_mfma_f32_32x32x16_bf16(b0, qr[0], z, 0, 0, 0); p1 = __builtin_amdgcn_mfma_f32_32x32x16_bf16(b1, qr[0], z, 0, 0, 0); }
        else { p0 = __builtin_amdgcn_mfma_f32_32x32x16_bf16(b0, qr[d0], p0, 0, 0, 0); p1 = __builtin_amdgcn_mfma_f32_32x32x16_bf16(b1, qr[d0], p1, 0, 0, 0); } }
}
template <int MODE, int KVP>
__device__ __forceinline__ void attn_unit_simple(const Unit& u, const bf16_t* Q, const bf16_t* __restrict__ K, const bf16_t* __restrict__ V, bf16_t* O, const float* rpb_h, char* shm) {
    const int tid = tid_opaque(), lane = tid & 63, r32 = lane & 31, hi = lane >> 5; const int wid = __builtin_amdgcn_readfirstlane(tid >> 6);
    const bf16_t* Qw = Q + (size_t)(u.qrow0 + wid * QBLK) * D + u.h * 64;
    const bf16_t* Kh = K + (size_t)u.kvrow0 * KVP + u.kvh * 64; const bf16_t* Vh = V + (size_t)u.kvrow0 * KVP + u.kvh * 64;
    const unsigned lds0 = (unsigned)(uintptr_t)shm;
    float* wsf = (float*)(shm + LDS_WS) + wid * 64;
    const bf16_t* ksrc = Kh + (long)lane * KVP + wid * 8;
    const bf16_t* vsrc = Vh + (long)(16 * (wid & 3) + (lane >> 2)) * KVP + (wid >> 2) * 32 + (lane & 3) * 8;
    const unsigned kdst = lds0 + LDS_K + wid * 1024, vdst = lds0 + LDS_V + wid * 1024;
    const int T0 = u.T0;
#define TPOS(t) ((long)(((t) < 4) ? (SEQ + 64 * (t)) : 64 * (T0 + (t) - 4)) * KVP)
#define DMA_K(t, slot) glds16(ksrc + TPOS(t), (unsigned)__builtin_amdgcn_readfirstlane(kdst + (slot)))
#define DMA_V(t, slot) glds16(vsrc + TPOS(t), (unsigned)__builtin_amdgcn_readfirstlane(vdst + (slot)))
    const int vb0 = (int)(lds0 + LDS_V) + ((lane >> 4) & 1) * 32 + (lane & 3) * 8 + (4 * hi + ((lane & 15) >> 2)) * 64;
    const lds_cptr shm3 = (lds_cptr)shm; const lds_cptr kp0 = shm3 + LDS_K + hi * 1024 + r32 * 16;
    const lds_cptr btab = shm3 + LDS_BIAS;
    const int NT = 4 + u.NL;
    DMA_K(0, 0); DMA_V(0, 0);
    MaskLane ml; ml.swa_base = 0; ml.rq = 0; ml.rs = 0; ml.c = 0; ml.cs = 0;
    if (MODE == 1) ml.swa_base = 64 * T0 - (u.tq0 + wid * QBLK + r32) + 128 + 4 * hi;
    if (MODE == 2) { ml.rq = (u.tq0 >> 6) + (wid >> 1); int rs = ml.rq - 4; ml.rs = rs < 0 ? 0 : (rs > 56 ? 56 : rs); ml.c = 32 * (wid & 1) + r32; int cs = ml.c - 8; ml.cs = cs < 0 ? 0 : (cs > 48 ? 48 : cs);
        if (tid < 15 * 31) ((float*)(shm + LDS_BIAS))[tid] = rpb_h[tid] * LOG2E; }
    bf16x8 qr[4];
#pragma unroll
    for (int d0 = 0; d0 < 4; ++d0) qr[d0] = *reinterpret_cast<const bf16x8*>(&Qw[(long)r32 * D + d0 * 16 + hi * 8]);
    float mhat = -INFINITY, l_reg = 0.f; f32x16 o[2]; o[0] = f32x16{}; o[1] = f32x16{};
    int slot = 0;
    for (int t = 0; t < NT; ++t) {
        asm volatile("s_waitcnt vmcnt(0) lgkmcnt(0)\n\ts_barrier" ::: "memory");
        if (t + 1 < NT) { DMA_K(t + 1, slot ^ SLOTB); DMA_V(t + 1, slot ^ SLOTB); }
        f32x16 p0, p1;
        qkt_lds(p0, p1, kp0 + slot, qr);
        asm volatile("s_nop 15\n\ts_nop 7" : "+v"(p0), "+v"(p1));
        amask<MODE>(p0, p1, t, u, ml, hi, btab);
        float a = __builtin_fmaxf(p0[0], p1[0]);
#pragma unroll
        for (int r = 1; r < 16; ++r) a = __builtin_fmaxf(a, __builtin_fmaxf(p0[r], p1[r]));
        { auto rr = __builtin_amdgcn_permlane32_swap(__float_as_uint(a), __float_as_uint(a), false, false); a = __builtin_fmaxf(__uint_as_float(rr[0]), __uint_as_float(rr[1])); }
        const float mnew = __builtin_fmaxf(mhat, a);
        const float alpha = __builtin_amdgcn_exp2f(mhat - mnew);
        mhat = mnew;
        float sacc = 0.f;
#pragma unroll
        for (int r = 0; r < 16; ++r) { p0[r] = __builtin_amdgcn_exp2f(p0[r] - mnew); p1[r] = __builtin_amdgcn_exp2f(p1[r] - mnew); sacc += p0[r] + p1[r]; }
        l_reg = l_reg * alpha + sacc;
        if (__any(alpha != 1.0f)) {
            if (hi == 0) wsf[r32] = alpha;
            asm volatile("s_waitcnt lgkmcnt(0)" ::: "memory");
#pragma unroll
            for (int r = 0; r < 16; ++r) { const float f = wsf[crow(r, hi)]; o[0][r] *= f; o[1][r] *= f; }
        }
        u32x4 pw0, pw1, pw2, pw3;
        pw0 = (u32x4){cvtpk_s(p0[0], p0[1]), cvtpk_s(p0[2], p0[3]), cvtpk_s(p0[4], p0[5]), cvtpk_s(p0[6], p0[7])};
        pw1 = (u32x4){cvtpk_s(p0[8], p0[9]), cvtpk_s(p0[10], p0[11]), cvtpk_s(p0[12], p0[13]), cvtpk_s(p0[14], p0[15])};
        pw2 = (u32x4){cvtpk_s(p1[0], p1[1]), cvtpk_s(p1[2], p1[3]), cvtpk_s(p1[4], p1[5]), cvtpk_s(p1[6], p1[7])};
        pw3 = (u32x4){cvtpk_s(p1[8], p1[9]), cvtpk_s(p1[10], p1[11]), cvtpk_s(p1[12], p1[13]), cvtpk_s(p1[14], p1[15])};
        SBAR();
        pv(o, vb0 + slot, __builtin_bit_cast(bf16x8, pw0), __builtin_bit_cast(bf16x8, pw1), __builtin_bit_cast(bf16x8, pw2), __builtin_bit_cast(bf16x8, pw3));
        slot ^= SLOTB;
    }
    { auto rr = __builtin_amdgcn_permlane32_swap(__float_as_uint(l_reg), __float_as_uint(l_reg), false, false); l_reg = __uint_as_float(rr[0]) + __uint_as_float(rr[1]); }
    if (u.has_sink) l_reg += __builtin_amdgcn_exp2f(u.sink_l2 - mhat);
    if (hi == 0) wsf[32 + r32] = l_reg; asm volatile("s_waitcnt lgkmcnt(0)" ::: "memory");
    float rli[16];
#pragma unroll
    for (int r = 0; r < 16; ++r) rli[r] = __builtin_amdgcn_rcpf(wsf[32 + crow(r, hi)]);
    bf16_t* Ow = O + (size_t)(u.qrow0 + wid * QBLK) * D + u.h * 64;
    { bf16_t* stg = (bf16_t*)(shm + LDS_OST) + wid * 2048;
#pragma unroll
      for (int r = 0; r < 16; ++r) { const int orow = crow(r, hi);
#pragma unroll
          for (int d0 = 0; d0 < 2; ++d0) stg[orow * 64 + d0 * 32 + r32] = (bf16_t)f2bf(o[d0][r] * rli[r]); }
      asm volatile("s_waitcnt lgkmcnt(0)" ::: "memory");
#pragma unroll
      for (int i = 0; i < 4; ++i) { const int row = i * 8 + (lane >> 3), ch = lane & 7; const u32x4 v = *(const u32x4*)(stg + row * 64 + ch * 8); *(u32x4*)(Ow + (long)row * D + ch * 8) = v; } }
    asm volatile("s_waitcnt lgkmcnt(0)\n\ts_barrier" ::: "memory");
#undef DMA_K
#undef DMA_V
#undef TPOS
}
#undef SBAR
#undef WAIT_BAR
}

template <int L> __device__ __forceinline__ void ph_attn_fast(const Params& P, LAS unsigned char* lds) {
    constexpr int kind = kind_of(L), kvw = kvw_of(L); constexpr bool last = (L == DEPTH - 1);
    constexpr int MODE = kind == 0 ? 2 : (kind == 1 ? 1 : 0);
    const LayerW lw = layer_w(P, L);
    const bf16_t* Qb = (const bf16_t*)(P.ws + WS_Q); const bf16_t* Kb = (const bf16_t*)(P.ws + WS_K); const bf16_t* Vb = (const bf16_t*)(P.ws + WS_V);
    bf16_t* Ob = (bf16_t*)(P.ws + WS_O);
    char* shm = (char*)lds;
    const int G = gridDim.x, bx = blockIdx.x; const int vcu = (G % 8 == 0) ? (bx % 8) * (G / 8) + bx / 8 : bx;
    for (int uix = vcu * 4; uix < 1024; uix += G * 4) {
        for (int i = 0; i < 4; ++i) {
            const int ui = uix + i, bh = ui >> 4, qb = ui & 15, b = bh >> 4, h = bh & 15;
            att::Unit u; u.qrow0 = b * SEQ + qb * 256; u.kvrow0 = b * KVROWS; u.h = h; u.kvh = kind == 0 ? h : (h >> 2); u.tq0 = qb * 256;
            u.has_sink = kind == 1 ? 1 : 0; u.sink_l2 = kind == 1 ? lw.sink[h] * LOG2E : 0.f;
            if (kind == 2) { u.T0 = 0; u.NL = 64; }
            else if (kind == 1) { const int lo = 4 * qb - 2 < 0 ? 0 : 4 * qb - 2, hi_ = 4 * qb + 6 > 64 ? 64 : 4 * qb + 6; u.T0 = lo; u.NL = hi_ - lo; }
            else { if (qb == 0) { u.T0 = 0; u.NL = 8; } else if (qb == 15) { u.T0 = 56; u.NL = 8; } else { u.T0 = 4 * qb - 4; u.NL = 12; } }
            if constexpr (MODE == 0) att::attn_unit<0, kvw, 8>(u, Qb, Kb, Vb, Ob, nullptr, shm);
            else att::attn_unit_simple<MODE, kvw>(u, Qb, Kb, Vb, Ob, kind == 0 ? lw.rpb + (size_t)h * 15 * 31 : nullptr, shm);
        }
    }
    if (!last) {
        for (int ui = vcu; ui < 64; ui += G) {
            const int b = ui >> 4, h = ui & 15;
            att::Unit u; u.qrow0 = MLAT + b * CTX; u.kvrow0 = b * KVROWS; u.h = h; u.kvh = kind == 0 ? h : (h >> 2); u.tq0 = 0; u.T0 = 0; u.NL = 0;
            u.has_sink = kind == 1 ? 1 : 0; u.sink_l2 = kind == 1 ? lw.sink[h] * LOG2E : 0.f;
            att::attn_unit<0, kvw, 8>(u, Qb, Kb, Vb, Ob, nullptr, shm);
        }
    }
}

#define XB_TMO      128
#define XB_XCNT(j)  (256  + 64 * (j))
#define XB_XSUB(j)  (1280 + 64 * (j))
#define XB_XGEN(j)  (2304 + 64 * (j))
#define XB_TOP      3328
#define XB_TOPGEN   3392
#define XCD_BAR_WORDS 3456
#define XB_SPIN_CAP (1u << 18)

__device__ __forceinline__ unsigned xb_ld(unsigned* p)              { return __hip_atomic_load(p, __ATOMIC_RELAXED, __HIP_MEMORY_SCOPE_AGENT); }
__device__ __forceinline__ unsigned xb_add(unsigned* p, unsigned v) { return __hip_atomic_fetch_add(p, v, __ATOMIC_RELAXED, __HIP_MEMORY_SCOPE_AGENT); }
__device__ __forceinline__ unsigned xb_xcc_id() { return (unsigned)__builtin_amdgcn_s_getreg((3 << 11) | 20) & 0xFu; }
#define XB_SPIN(cond, bar) do { unsigned _sp = 0; while (cond) { __builtin_amdgcn_s_sleep(1); \
    if ((++_sp & 255u) == 0u) { if (xb_ld(&(bar)[XB_TMO])) break; if (_sp > XB_SPIN_CAP) { atomicAdd(&(bar)[XB_TMO], 1u); break; } } } } while (0)

struct XcdBarrier {
    unsigned* bar; unsigned x;
    volatile LAS unsigned* st;
};

__device__ __forceinline__ XcdBarrier xcd_barrier_post(unsigned* bar, volatile LAS unsigned* st) {
    XcdBarrier b; b.bar = bar; b.x = xb_xcc_id(); b.st = st;
    if (threadIdx.x == 0) (void)xb_add(&bar[XB_XCNT(b.x)], 1u);
    return b;
}
__device__ __forceinline__ void xcd_barrier_complete(unsigned* bar, unsigned x, unsigned& nloc, unsigned& nx) {
    const unsigned G = gridDim.x * gridDim.y * gridDim.z;
    unsigned sum, cnt, mine, sp = 0u;
    for (;;) {
        sum = 0u; cnt = 0u; mine = 0u;
#pragma unroll
        for (unsigned j = 0; j < 16; ++j) { const unsigned c = xb_ld(&bar[XB_XCNT(j)]); sum += c; cnt += (c > 0u) ? 1u : 0u; mine = (j == x) ? c : mine; }
        if (sum == G) break;
        __builtin_amdgcn_s_sleep(1);
        if ((++sp & 255u) == 0u) { if (xb_ld(&bar[XB_TMO])) break; if (sp > XB_SPIN_CAP) { atomicAdd(&bar[XB_TMO], 1u); break; } }
    }
    nloc = mine > 0u ? mine : 1u; nx = cnt > 0u ? cnt : 1u;
}

__device__ __forceinline__ void xcd_barrier(const XcdBarrier& b) {
    asm volatile("s_waitcnt vmcnt(0)" ::: "memory");
    __syncthreads();
    if (threadIdx.x == 0) {
        unsigned* bar = b.bar;
        __builtin_amdgcn_s_waitcnt(0);
        unsigned nloc = b.st[0], nx = b.st[1];
        if (nloc == 0u) { xcd_barrier_complete(bar, b.x, nloc, nx); b.st[0] = nloc; b.st[1] = nx; }
        const unsigned old = xb_add(&bar[XB_XSUB(b.x)], 1u);
        const unsigned gen = old / nloc;
        if (old + 1u == (gen + 1u) * nloc) {
            __builtin_amdgcn_fence(__ATOMIC_RELEASE, "agent");
            asm volatile("s_waitcnt vmcnt(0)" ::: "memory");
            const unsigned og = xb_add(&bar[XB_TOP], 1u);
            const unsigned tg = og / nx;
            if (og + 1u == (tg + 1u) * nx) xb_add(&bar[XB_TOPGEN], 1u);
            else XB_SPIN(xb_ld(&bar[XB_TOPGEN]) == tg, bar);
            __builtin_amdgcn_fence(__ATOMIC_ACQUIRE, "agent");
            xb_add(&bar[XB_XGEN(b.x)], 1u);
            asm volatile("s_waitcnt vmcnt(0)" ::: "memory");
        } else {
            XB_SPIN(xb_ld(&bar[XB_XGEN(b.x)]) == gen, bar);
            __builtin_amdgcn_fence(__ATOMIC_ACQUIRE, "agent");
            asm volatile("s_waitcnt vmcnt(0)" ::: "memory");
        }
    }
    __syncthreads();
}

constexpr int STAGES = 6, NPHASES = 2 + DEPTH * STAGES;
constexpr int LDS_BYTES = 147456, LDS_MISC = LDS_BYTES - 64;
constexpr int CH0_ROWS = 8192;


#ifndef PROBE_KIND
#define PROBE_KIND 0
#endif
#ifndef PROBE_N
#define PROBE_N 4
#endif
#ifndef REP_SYNC
#define REP_SYNC 1
#endif
#ifndef REP_ATTN
#define REP_ATTN 1
#endif
#define PHASE(k, body) do { if (P.ph_lo <= (k) && (k) < P.ph_hi) { body; if ((k) + 1 < P.ph_hi) { for (int rs_ = 0; rs_ < REP_SYNC; ++rs_) { if ((k) == 0) grid.sync(); else xcd_barrier(bar); } } } } while (0)

template <int L> __device__ __forceinline__ void run_layer(const Params& P, cg::grid_group& grid, const XcdBarrier& bar, LAS unsigned char* lds, int wave, int lane) {
    constexpr bool last = (L == DEPTH - 1);
    constexpr int nrows = last ? MLAT : MTOT;
    constexpr int k0 = 2 + L * STAGES;
    constexpr int LN = last ? L : L + 1;
    PHASE(k0 + 0, ph_qkv_fast<L>(P, lds));
    PHASE(k0 + 1, { for (int ra_ = 0; ra_ < REP_ATTN; ++ra_) ph_attn_fast<L>(P, lds); });
    PHASE(k0 + 2, ph_resid_fast(P, L, lds, (const bf16_t*)(P.ws + WS_O), D, wt_o(P, L), 2048, nrows, P.in[7] + L * D, mod_ptr(P, L, 0) + 4096));
    PHASE(k0 + 3, ph_upconv_fast(P, L, lds, nrows));
    PHASE(k0 + 4, ph_fix(P, L, nrows));
    PHASE(k0 + 5, ph_resid_fast(P, L, lds, (const bf16_t*)(P.ws + WS_ACT), DFF, wt_dn(P, L), 5120, nrows, last ? nullptr : P.in[6] + LN * D, mod_ptr(P, LN, 0) + 1024));
}

__global__ void __launch_bounds__(NTHREADS, 2) fwd_kernel(Params P) {
    extern __shared__ __attribute__((aligned(16))) unsigned char lds_raw[];
    LAS unsigned char* lds = (LAS unsigned char*)lds_raw;
    cg::grid_group grid = cg::this_grid();
    const int wave = 0, lane = 0; (void)wave; (void)lane;
    volatile LAS unsigned* MISC = (volatile LAS unsigned*)(lds + LDS_MISC);
    { const int t0_ = tid_opaque(); if (t0_ < 16) MISC[t0_] = 0u; }
    __syncthreads();
    const XcdBarrier bar = xcd_barrier_post((unsigned*)(P.ws + WS_BAR), MISC + 8);
    PHASE(0, ph_prologue(P, lds));
    PHASE(1, ph_prologue_b(P));
    run_layer<0>(P, grid, bar, lds, wave, lane);
    run_layer<1>(P, grid, bar, lds, wave, lane);
    run_layer<2>(P, grid, bar, lds, wave, lane);
    run_layer<3>(P, grid, bar, lds, wave, lane);
#if PROBE_KIND != 0
    for (int pr_ = 0; pr_ < PROBE_N; ++pr_) {
        xcd_barrier(bar);
#if PROBE_KIND == 1
        ph_qkv_fast<0>(P, lds);
#elif PROBE_KIND == 2
        ph_qkv_fast<1>(P, lds);
#elif PROBE_KIND == 3
        ph_attn_fast<0>(P, lds);
#elif PROBE_KIND == 4
        ph_attn_fast<1>(P, lds);
#elif PROBE_KIND == 5
        ph_attn_fast<2>(P, lds);
#elif PROBE_KIND == 6
        ph_resid_fast(P, 0, lds, (const bf16_t*)(P.ws + WS_ACT), D, wt_o(P, 0), 2048, MTOT, P.in[7], mod_ptr(P, 0, 0) + 4096, true);
#elif PROBE_KIND == 7
        ph_upconv_fast(P, 0, lds, MTOT);
#elif PROBE_KIND == 8
        ph_fix(P, 0, MTOT);
#elif PROBE_KIND == 9
        ph_resid_fast(P, 0, lds, (const bf16_t*)(P.ws + WS_ACT), DFF, wt_dn(P, 0), 5120, MTOT, P.in[6] + D, mod_ptr(P, 1, 0) + 1024, true);
#endif
    }
#endif
}

extern "C" void kernel_launch(void* const* d_in, const int* in_sizes, int n_in, void* d_out, int out_size, void* d_ws, size_t ws_size, hipStream_t stream) {
    static int grid_blocks = 0;
    if (grid_blocks == 0) {
        if (n_in != 26 || out_size != MLAT * D || ws_size < WS_END) { fprintf(stderr, "kernel_launch: unexpected shapes (n_in %d out %d ws %zu)\n", n_in, out_size, ws_size); grid_blocks = -1; return; }
        int dev = 0, cus = 0, per_cu = 0;
        (void)hipGetDevice(&dev);
        (void)hipDeviceGetAttribute(&cus, hipDeviceAttributeMultiprocessorCount, dev);
        (void)hipFuncSetAttribute((const void*)fwd_kernel, hipFuncAttributeMaxDynamicSharedMemorySize, LDS_BYTES);
        (void)hipOccupancyMaxActiveBlocksPerMultiprocessor(&per_cu, (const void*)fwd_kernel, NTHREADS, LDS_BYTES);
        (void)hipGetLastError();
        if (per_cu < 1) per_cu = 1;
        grid_blocks = cus * per_cu;
        fprintf(stderr, "kernel_launch: %d CUs x %d blocks\n", cus, per_cu);
    }
    if (grid_blocks < 0) return;
    if (hipMemsetAsync(d_ws, 0, WS_CTL_BYTES, stream) != hipSuccess) { fprintf(stderr, "kernel_launch: memset failed\n"); return; }
    Params p{};
    for (int i = 0; i < 26; ++i) p.in[i] = (const float*)d_in[i];
    p.out = (float*)d_out; p.ws = (unsigned char*)d_ws; p.ph_lo = 0; p.ph_hi = NPHASES;
    void* args[] = {&p};
    hipError_t e = hipLaunchCooperativeKernel((const void*)fwd_kernel, dim3(grid_blocks), dim3(NTHREADS), args, LDS_BYTES, stream);
    if (e != hipSuccess) fprintf(stderr, "cooperative launch failed: %s (grid %d)\n", hipGetErrorString(e), grid_blocks);
}
```

```cpp
#include <hip/hip_runtime.h>
#include <hip/hip_cooperative_groups.h>
#include <cstdio>
#include <cstdint>
namespace cg = cooperative_groups;
#ifndef FAST_QKV
#define FAST_QKV 1
#endif
#ifndef FAST_RESID
#define FAST_RESID 1
#endif
#ifndef FAST_UP
#define FAST_UP 1
#endif
#ifndef FAST_ATTN
#define FAST_ATTN 1
#endif

#define LAS __attribute__((address_space(3)))
typedef unsigned short bf16_t;
typedef short bf16x8 __attribute__((ext_vector_type(8)));
typedef float f32x4 __attribute__((ext_vector_type(4)));
typedef unsigned u32x4 __attribute__((ext_vector_type(4)));
typedef unsigned u32x2 __attribute__((ext_vector_type(2)));

constexpr int D = 1024, NB = 4, SEQ = 4096, CTX = 256, DEPTH = 4;
constexpr int MLAT = NB * SEQ, MCTX = NB * CTX, MTOT = MLAT + MCTX;
constexpr int DFF = 2816, NUP = 2 * DFF;
constexpr int NH = 16, HD = 64;
constexpr int KVROWS = SEQ + CTX;
constexpr int NWAVES = 8, NTHREADS = NWAVES * 64;
constexpr float RMS_EPS = 1e-6f;
constexpr float LOG2E = 1.4426950408889634f;
constexpr float C2 = 0.125f * LOG2E;

__host__ __device__ constexpr int kind_of(int l) { return l % 3; }
__host__ __device__ constexpr int kvw_of(int l) { return kind_of(l) == 0 ? 1024 : 256; }
__host__ __device__ constexpr int nqkv_of(int l) { return 1024 + 2 * kvw_of(l); }
__host__ __device__ constexpr size_t wl_size(int l) { return (size_t)nqkv_of(l) * D + (size_t)D * D + (size_t)NUP * D + (size_t)D * DFF; }
__host__ __device__ constexpr size_t wl_off(int l) { size_t o = 0; for (int i = 0; i < l; ++i) o += wl_size(i); return o; }

constexpr size_t MiB = 1u << 20;
constexpr size_t WS_BAR = 16384, WS_CTL_BYTES = 65536;
constexpr size_t WS_MOD = 1 * MiB;
constexpr size_t WS_ROPE = 1 * MiB + 768 * 1024;
constexpr size_t WS_STATS = 6 * MiB;
constexpr size_t WS_BQKV = 7 * MiB + 256 * 1024;
constexpr size_t WS_BUP = 7 * MiB + 512 * 1024;
constexpr size_t WS_CTXRES = 2 * MiB;
constexpr size_t WS_W = 8 * MiB;
constexpr size_t WS_H = 100 * MiB;
constexpr size_t WS_Q = 134 * MiB;
constexpr size_t WS_K = 168 * MiB;
constexpr size_t WS_V = 202 * MiB;
constexpr size_t WS_O = 236 * MiB;
constexpr size_t WS_ACT = 270 * MiB;
constexpr size_t WS_HB = 134 * MiB;
constexpr size_t WS_U = 134 * MiB;
constexpr size_t WS_END = 364 * MiB;
static_assert(WS_W + wl_off(DEPTH) * 2 <= WS_H, "weights fit");
static_assert(WS_U + (size_t)9216 * NUP * 2 <= WS_ACT, "u chunk fits");
static_assert(WS_ACT + (size_t)MTOT * DFF * 2 <= WS_END, "act fits");

struct Params { const float* in[26]; float* out; unsigned char* ws; int ph_lo, ph_hi; };

__device__ __forceinline__ int tid_opaque() { int t = threadIdx.x; asm volatile("" : "+v"(t)); return t; }
__device__ __forceinline__ unsigned f2bf(float f) { unsigned u = __builtin_bit_cast(unsigned, f); return (u + 0x7fffu + ((u >> 16) & 1u)) >> 16; }
__device__ __forceinline__ unsigned pk2(float lo, float hi) { return f2bf(lo) | (f2bf(hi) << 16); }
__device__ __forceinline__ float bf_lo(unsigned w) { return __builtin_bit_cast(float, w << 16); }
__device__ __forceinline__ float bf_hi(unsigned w) { return __builtin_bit_cast(float, w & 0xffff0000u); }
__device__ __forceinline__ float wave_sum(float v) {
#pragma unroll
    for (int o = 1; o < 64; o <<= 1) v += __shfl_xor(v, o);
    return v;
}
__device__ __forceinline__ float silu_f(float x) { return x / (1.f + __expf(-x)); }
__device__ __forceinline__ float* xrow_ptr(const Params& P, int r) { return r < MLAT ? P.out + (size_t)r * D : (float*)(P.ws + WS_CTXRES) + (size_t)(r - MLAT) * D; }
__device__ __forceinline__ int cond_idx(int r) { return r < MLAT ? (r >> 12) : 4; }
__device__ __forceinline__ size_t kv_row(int r) { return r < MLAT ? (size_t)(r >> 12) * KVROWS + (r & 4095) : (size_t)((r - MLAT) >> 8) * KVROWS + SEQ + ((r - MLAT) & 255); }
__device__ __forceinline__ const float* mod_ptr(const Params& P, int l, int ci) { return (const float*)(P.ws + WS_MOD) + (size_t)(l * 5 + ci) * 6144; }

struct LayerW { const float *wqkv, *gq, *gk, *wo, *rpb, *sink; };
__device__ __forceinline__ LayerW layer_w(const Params& P, int l) {
    LayerW w; const int kind = kind_of(l), j = l / 3;
    if (kind == 0) { w.wqkv = P.in[8] + (size_t)j * D * 3072; w.gq = P.in[9] + j * 64; w.gk = P.in[10] + j * 64; w.rpb = P.in[11] + (size_t)j * NH * 15 * 31; w.wo = P.in[12] + (size_t)j * D * D; w.sink = nullptr; }
    else if (kind == 1) { w.wqkv = P.in[13] + (size_t)j * D * 1536; w.gq = P.in[14] + j * 64; w.gk = P.in[15] + j * 64; w.sink = P.in[16] + j * NH; w.wo = P.in[17] + (size_t)j * D * D; w.rpb = nullptr; }
    else { w.wqkv = P.in[18] + (size_t)j * D * 1536; w.gq = P.in[19] + j * 64; w.gk = P.in[20] + j * 64; w.wo = P.in[21] + (size_t)j * D * D; w.rpb = nullptr; w.sink = nullptr; }
    return w;
}
__device__ __forceinline__ bf16_t* wt_qkv(const Params& P, int l) { return (bf16_t*)(P.ws + WS_W) + wl_off(l); }
__device__ __forceinline__ bf16_t* wt_o(const Params& P, int l) { return wt_qkv(P, l) + (size_t)nqkv_of(l) * D; }
__device__ __forceinline__ bf16_t* wt_up(const Params& P, int l) { return wt_o(P, l) + (size_t)D * D; }
__device__ __forceinline__ bf16_t* wt_dn(const Params& P, int l) { return wt_up(P, l) + (size_t)NUP * D; }

__device__ __forceinline__ int phys_qkv(int c) { return (c & ~255) + 128 * ((c >> 5) & 1) + 32 * ((c >> 6) & 3) + (c & 31); }
__device__ __forceinline__ int phys_up(int c) { const int bj = c >= DFF ? 1 : 0, cc = c - bj * DFF; return 256 * (cc >> 7) + 128 * bj + (cc & 127); }

__device__ __forceinline__ void transpose_item(const float* W, int K, int N, bf16_t* WT, int mode, LAS float* scr, int item, int lane) {
    const int nblk = N / 32, kb = item / nblk, nb = item % nblk, k0 = 64 * kb, n0 = 32 * nb;
#pragma unroll 8
    for (int i = 0; i < 32; ++i) { const int kk = 2 * i + (lane >> 5); scr[kk * 33 + (lane & 31)] = W[(size_t)(k0 + kk) * N + n0 + (lane & 31)]; }
    asm volatile("s_waitcnt lgkmcnt(0)" ::: "memory");
    const int p0 = mode == 1 ? phys_qkv(n0) : (mode == 2 ? phys_up(n0) : n0);
    const int c = lane & 7;
#pragma unroll
    for (int j = 0; j < 4; ++j) { const int n = (lane >> 3) + 8 * j; const LAS float* s = scr + (8 * c) * 33 + n;
        u32x4 o; o.x = pk2(s[0 * 33], s[1 * 33]); o.y = pk2(s[2 * 33], s[3 * 33]); o.z = pk2(s[4 * 33], s[5 * 33]); o.w = pk2(s[6 * 33], s[7 * 33]);
        *(u32x4*)(WT + (size_t)(p0 + n) * K + k0 + 8 * c) = o; }
    asm volatile("s_waitcnt lgkmcnt(0)" ::: "memory");
}

template <int L> __device__ __forceinline__ void prologue_weights(const Params& P, LAS float* scr, int gw, int NGW, int lane) {
    const LayerW lw = layer_w(P, L); constexpr int nq = nqkv_of(L);
    constexpr int I_Q = (D / 64) * (nq / 32), I_O = (D / 64) * (D / 32), I_U = (D / 64) * (NUP / 32), I_D = (DFF / 64) * (D / 32);
    constexpr int NIT = I_Q + I_O + I_U + I_D;
    for (int it = gw; it < NIT; it += NGW) {
        int r = it;
        if (r < I_Q) { transpose_item(lw.wqkv, D, nq, wt_qkv(P, L), 1, scr, r, lane); continue; } r -= I_Q;
        if (r < I_O) { transpose_item(lw.wo, D, D, wt_o(P, L), 0, scr, r, lane); continue; } r -= I_O;
        if (r < I_U) { transpose_item(P.in[22] + (size_t)L * D * NUP, D, NUP, wt_up(P, L), 2, scr, r, lane); continue; } r -= I_U;
        transpose_item(P.in[25] + (size_t)L * DFF * D, DFF, D, wt_dn(P, L), 0, scr, r, lane);
    }
}

__device__ __forceinline__ void ph_prologue(const Params& P, LAS unsigned char* lds) {
    const int tid = tid_opaque(), wave = __builtin_amdgcn_readfirstlane(tid >> 6), lane = tid & 63;
    if (blockIdx.x == 0) {
        float* tab = (float*)(P.ws + WS_ROPE);
        for (int idx = tid; idx < 64 * 16; idx += NTHREADS) { const int pos = idx >> 4, f = idx & 15;
            const float inv = powf(10000.0f, -(float)f / 16.0f); const float ang = (float)pos * inv;
            tab[2 * idx] = cosf(ang); tab[2 * idx + 1] = sinf(ang); }
    }
    {
        LAS float* sil = (LAS float*)lds;
        LAS float* part = (LAS float*)(lds + 20480);
        for (int i = tid; i < 5 * 1024; i += NTHREADS) { const int ci = i >> 10, k = i & 1023; const float c = ci < 4 ? P.in[1][ci * D + k] : P.in[3][k]; sil[i] = silu_f(c); }
        __syncthreads();
        for (int it = blockIdx.x; it < DEPTH * 96; it += gridDim.x) {
            const int l = it / 96, n = (it % 96) * 64 + lane;
            const float* w = P.in[4] + (size_t)l * D * 6144 + n;
            float a0 = 0.f, a1 = 0.f, a2 = 0.f, a3 = 0.f, a4 = 0.f;
            const int kbeg = wave * 128;
#pragma unroll 8
            for (int k = kbeg; k < kbeg + 128; ++k) { const float wv = w[(size_t)k * 6144];
                a0 += sil[k] * wv; a1 += sil[1024 + k] * wv; a2 += sil[2048 + k] * wv; a3 += sil[3072 + k] * wv; a4 += sil[4096 + k] * wv; }
            part[(wave * 5 + 0) * 64 + lane] = a0; part[(wave * 5 + 1) * 64 + lane] = a1; part[(wave * 5 + 2) * 64 + lane] = a2; part[(wave * 5 + 3) * 64 + lane] = a3; part[(wave * 5 + 4) * 64 + lane] = a4;
            __syncthreads();
            if (tid < 320) { const int ci = tid >> 6, ln = tid & 63; float s = 0.f;
#pragma unroll
                for (int w8 = 0; w8 < 8; ++w8) s += part[(w8 * 5 + ci) * 64 + ln];
                const int nn = (it % 96) * 64 + ln;
                ((float*)(P.ws + WS_MOD))[(size_t)(l * 5 + ci) * 6144 + nn] = s + P.in[5][l * 6144 + nn]; }
            __syncthreads();
        }
    }
    const int gw = blockIdx.x * NWAVES + wave, NGW = gridDim.x * NWAVES;
    {
        LAS float* scr = (LAS float*)(lds + 32768 + wave * 8704);
        prologue_weights<0>(P, scr, gw, NGW, lane); prologue_weights<1>(P, scr, gw, NGW, lane);
        prologue_weights<2>(P, scr, gw, NGW, lane); prologue_weights<3>(P, scr, gw, NGW, lane);
    }
}


template <int L> __device__ __forceinline__ void prologue_bias(const Params& P, int gw, int NGW, int lane) {
    constexpr int nq = nqkv_of(L), NIT = (nq + NUP) / 8;
    for (int it = gw; it < NIT; it += NGW) {
        const int p0 = it * 8; const bool isq = p0 < nq;
        const bf16_t* W = isq ? wt_qkv(P, L) + (size_t)p0 * D : wt_up(P, L) + (size_t)(p0 - nq) * D;
        float* dst = isq ? (float*)(P.ws + WS_BQKV) + (size_t)L * 5 * 3072 + p0 : (float*)(P.ws + WS_BUP) + (size_t)L * 5 * NUP + (p0 - nq);
        const int dstride = isq ? nq : NUP;
        f32x4 sh[5][4];
#pragma unroll
        for (int ci = 0; ci < 5; ++ci) { const float* sp = mod_ptr(P, L, ci) + (isq ? 0 : 3072) + 16 * lane;
#pragma unroll
            for (int q = 0; q < 4; ++q) sh[ci][q] = *(const f32x4*)(sp + 4 * q); }
        for (int rr = 0; rr < 8; ++rr) {
            const u32x4 w0 = *(const u32x4*)(W + (size_t)rr * D + 16 * lane), w1 = *(const u32x4*)(W + (size_t)rr * D + 16 * lane + 8);
            const f32x4 wf[4] = {(f32x4){bf_lo(w0.x), bf_hi(w0.x), bf_lo(w0.y), bf_hi(w0.y)}, (f32x4){bf_lo(w0.z), bf_hi(w0.z), bf_lo(w0.w), bf_hi(w0.w)},
                                 (f32x4){bf_lo(w1.x), bf_hi(w1.x), bf_lo(w1.y), bf_hi(w1.y)}, (f32x4){bf_lo(w1.z), bf_hi(w1.z), bf_lo(w1.w), bf_hi(w1.w)}};
#pragma unroll
            for (int ci = 0; ci < 5; ++ci) { f32x4 a = sh[ci][0] * wf[0] + sh[ci][1] * wf[1] + sh[ci][2] * wf[2] + sh[ci][3] * wf[3];
                const float t = wave_sum((a.x + a.y) + (a.z + a.w));
                if (lane == 0) dst[(size_t)ci * dstride + rr] = t; }
        }
    }
}

__device__ __forceinline__ void ph_prologue_b(const Params& P) {
    const int tid = tid_opaque(), wave = __builtin_amdgcn_readfirstlane(tid >> 6), lane = tid & 63;
    const int gw = blockIdx.x * NWAVES + wave, NGW = gridDim.x * NWAVES;
    bf16_t* H = (bf16_t*)(P.ws + WS_H); float* stats = (float*)(P.ws + WS_STATS);
    const float* g = P.in[6];
    for (int r = gw; r < MTOT; r += NGW) {
        const f32x4* xs = (r < MLAT ? (const f32x4*)(P.in[0] + (size_t)r * D) : (const f32x4*)(P.in[2] + (size_t)(r - MLAT) * D)) + lane;
        f32x4* xd = (f32x4*)xrow_ptr(P, r) + lane;
        const float* md = mod_ptr(P, 0, cond_idx(r));
        u32x2* o8 = (u32x2*)(H + (size_t)r * D) + lane;
        float ss = 0.f;
#pragma unroll
        for (int j = 0; j < 4; ++j) { const f32x4 v = xs[64 * j]; xd[64 * j] = v; ss += (v.x * v.x + v.y * v.y) + (v.z * v.z + v.w * v.w);
            const int c = 4 * lane + 256 * j; const f32x4 gg = *(const f32x4*)(g + c), sc = *(const f32x4*)(md + 1024 + c);
            const f32x4 hh = v * (gg * (sc + 1.0f)); u32x2 w; w.x = pk2(hh.x, hh.y); w.y = pk2(hh.z, hh.w); o8[64 * j] = w; }
        ss = wave_sum(ss);
        if (lane < 16) stats[(size_t)r * 16 + lane] = lane == 0 ? ss : 0.f;
    }
    prologue_bias<0>(P, gw, NGW, lane); prologue_bias<1>(P, gw, NGW, lane); prologue_bias<2>(P, gw, NGW, lane); prologue_bias<3>(P, gw, NGW, lane);
}

__device__ __forceinline__ void ph_norm(const Params& P, int l, int which, int nrows, int wave, int lane) {
    const int gw = blockIdx.x * NWAVES + wave, NGW = gridDim.x * NWAVES;
    const float* g = (which == 0 ? P.in[6] : P.in[7]) + l * D;
    bf16_t* H = (bf16_t*)(P.ws + WS_H);
    for (int r = gw; r < nrows; r += NGW) {
        const f32x4* xr = (const f32x4*)xrow_ptr(P, r) + lane;
        const float* md = mod_ptr(P, l, cond_idx(r)) + (which == 0 ? 0 : 3072);
        f32x4 v[4]; float s = 0.f;
#pragma unroll
        for (int j = 0; j < 4; ++j) { v[j] = xr[64 * j]; s += (v[j].x * v[j].x + v[j].y * v[j].y) + (v[j].z * v[j].z + v[j].w * v[j].w); }
        const float rstd = 1.0f / sqrtf(wave_sum(s) * (1.f / D) + RMS_EPS);
        u32x2* o8 = (u32x2*)(H + (size_t)r * D) + lane;
#pragma unroll
        for (int j = 0; j < 4; ++j) { const int c = 4 * lane + 256 * j;
            const f32x4 gg = *(const f32x4*)(g + c), sh = *(const f32x4*)(md + c), sc = *(const f32x4*)(md + 1024 + c);
            const f32x4 y = (v[j] * rstd) * gg;
            const f32x4 hh = y * (sc + 1.0f) + sh;
            u32x2 w; w.x = pk2(hh.x, hh.y); w.y = pk2(hh.z, hh.w); o8[64 * j] = w; }
    }
}

__device__ __forceinline__ void wave_gemm(const bf16_t* a0p, const bf16_t* a1p, const bf16_t* b0, const bf16_t* b1, const bf16_t* b2, const bf16_t* b3, int K, f32x4 (&acc)[2][4]) {
#pragma unroll
    for (int m = 0; m < 2; ++m)
#pragma unroll
        for (int n = 0; n < 4; ++n) acc[m][n] = (f32x4){0.f, 0.f, 0.f, 0.f};
#pragma unroll 2
    for (int k = 0; k < K; k += 32) {
        const bf16x8 a0 = *(const bf16x8*)(a0p + k), a1 = *(const bf16x8*)(a1p + k);
        const bf16x8 w0 = *(const bf16x8*)(b0 + k), w1 = *(const bf16x8*)(b1 + k), w2 = *(const bf16x8*)(b2 + k), w3 = *(const bf16x8*)(b3 + k);
        acc[0][0] = __builtin_amdgcn_mfma_f32_16x16x32_bf16(w0, a0, acc[0][0], 0, 0, 0);
        acc[0][1] = __builtin_amdgcn_mfma_f32_16x16x32_bf16(w1, a0, acc[0][1], 0, 0, 0);
        acc[0][2] = __builtin_amdgcn_mfma_f32_16x16x32_bf16(w2, a0, acc[0][2], 0, 0, 0);
        acc[0][3] = __builtin_amdgcn_mfma_f32_16x16x32_bf16(w3, a0, acc[0][3], 0, 0, 0);
        acc[1][0] = __builtin_amdgcn_mfma_f32_16x16x32_bf16(w0, a1, acc[1][0], 0, 0, 0);
        acc[1][1] = __builtin_amdgcn_mfma_f32_16x16x32_bf16(w1, a1, acc[1][1], 0, 0, 0);
        acc[1][2] = __builtin_amdgcn_mfma_f32_16x16x32_bf16(w2, a1, acc[1][2], 0, 0, 0);
        acc[1][3] = __builtin_amdgcn_mfma_f32_16x16x32_bf16(w3, a1, acc[1][3], 0, 0, 0);
    }
}

__device__ __forceinline__ void ph_qkv(const Params& P, int l, int wave, int lane) {
    const int gw = blockIdx.x * NWAVES + wave, NGW = gridDim.x * NWAVES;
    const int kind = kind_of(l), kvw = kvw_of(l), nkvh = kvw / 64, nheads = 16 + 2 * nkvh;
    const bool last = (l == DEPTH - 1);
    const LayerW lw = layer_w(P, l);
    const bf16_t* H = (const bf16_t*)(P.ws + WS_H); const bf16_t* W = wt_qkv(P, l);
    bf16_t* Qb = (bf16_t*)(P.ws + WS_Q); bf16_t* Kb = (bf16_t*)(P.ws + WS_K); bf16_t* Vb = (bf16_t*)(P.ws + WS_V);
    const float* rope = (const float*)(P.ws + WS_ROPE);
    const int fr = lane & 15, fq = lane >> 4;
    const int nitems = (MTOT / 32) * nheads;
    for (int it = gw; it < nitems; it += NGW) {
        const int rb = it / nheads, hh = it % nheads, row0 = rb * 32;
        if (last && row0 >= MLAT && hh < 16) continue;
        const bf16_t* a0p = H + (size_t)(row0 + fr) * D + fq * 8; const bf16_t* a1p = a0p + (size_t)16 * D;
        const bf16_t* bp[4];
#pragma unroll
        for (int nt = 0; nt < 4; ++nt) { const int p = 256 * (hh >> 2) + 128 * (nt >> 1) + 32 * (hh & 3) + 16 * (nt & 1) + fr; bp[nt] = W + (size_t)p * D + fq * 8; }
        f32x4 acc[2][4];
        wave_gemm(a0p, a1p, bp[0], bp[1], bp[2], bp[3], D, acc);
        const int type = hh < 16 ? 0 : (hh < 16 + nkvh ? 1 : 2);
        const int hidx = type == 0 ? hh : (type == 1 ? hh - 16 : hh - 16 - nkvh);
#pragma unroll
        for (int mt = 0; mt < 2; ++mt) {
            const int row = row0 + 16 * mt + fr;
            f32x4 v[4];
#pragma unroll
            for (int nt = 0; nt < 4; ++nt) v[nt] = acc[mt][nt];
            if (type < 2) {
                float ss = 0.f;
#pragma unroll
                for (int nt = 0; nt < 4; ++nt) ss += (v[nt].x * v[nt].x + v[nt].y * v[nt].y) + (v[nt].z * v[nt].z + v[nt].w * v[nt].w);
                ss += __shfl_xor(ss, 16); ss += __shfl_xor(ss, 32);
                const float rinv = 1.0f / sqrtf(ss * (1.f / 64.f) + RMS_EPS);
                const float* gg = type == 0 ? lw.gq : lw.gk;
#pragma unroll
                for (int nt = 0; nt < 4; ++nt) { const f32x4 g4 = *(const f32x4*)(gg + 16 * nt + 4 * fq); v[nt] = (v[nt] * rinv) * g4; }
                if (kind != 0 && row < MLAT) {
                    const int t = row & 4095, prow = t >> 6, pcol = t & 63;
#pragma unroll
                    for (int nt = 0; nt < 2; ++nt) {
                        const float* tb = rope + ((nt == 0 ? prow : pcol) * 16 + 4 * fq) * 2;
                        const f32x4 t0 = *(const f32x4*)tb, t1 = *(const f32x4*)(tb + 4);
                        const f32x4 cs = (f32x4){t0.x, t0.z, t1.x, t1.z}, sn = (f32x4){t0.y, t0.w, t1.y, t1.w};
                        const f32x4 x1 = v[nt], x2 = v[nt + 2];
                        v[nt] = x1 * cs - x2 * sn; v[nt + 2] = x2 * cs + x1 * sn;
                    }
                }
                if (type == 0) {
#pragma unroll
                    for (int nt = 0; nt < 4; ++nt) v[nt] = v[nt] * C2;
                }
            }
            bf16_t* dst;
            if (type == 0) dst = Qb + (size_t)row * D + hidx * 64;
            else dst = (type == 1 ? Kb : Vb) + kv_row(row) * kvw + hidx * 64;
#pragma unroll
            for (int nt = 0; nt < 4; ++nt) { u32x2 w; w.x = pk2(v[nt].x, v[nt].y); w.y = pk2(v[nt].z, v[nt].w); *(u32x2*)(dst + 16 * nt + 4 * fq) = w; }
        }
    }
}

__device__ __forceinline__ void ph_resid_gemm(const Params& P, int l, const bf16_t* A, int K, const bf16_t* W, int gate_off, int nrows, int wave, int lane) {
    const int gw = blockIdx.x * NWAVES + wave, NGW = gridDim.x * NWAVES;
    const int fr = lane & 15, fq = lane >> 4;
    const int nitems = (nrows / 32) * 16;
    for (int it = gw; it < nitems; it += NGW) {
        const int rb = it >> 4, cb = it & 15, row0 = rb * 32, c0 = cb * 64;
        const bf16_t* a0p = A + (size_t)(row0 + fr) * K + fq * 8; const bf16_t* a1p = a0p + (size_t)16 * K;
        const bf16_t* bp = W + (size_t)(c0 + fr) * K + fq * 8;
        f32x4 acc[2][4];
        wave_gemm(a0p, a1p, bp, bp + (size_t)16 * K, bp + (size_t)32 * K, bp + (size_t)48 * K, K, acc);
        const float* gate = mod_ptr(P, l, cond_idx(row0)) + gate_off;
#pragma unroll
        for (int mt = 0; mt < 2; ++mt) { float* xr = xrow_ptr(P, row0 + 16 * mt + fr);
#pragma unroll
            for (int nt = 0; nt < 4; ++nt) { const int c = c0 + 16 * nt + 4 * fq; const f32x4 g4 = *(const f32x4*)(gate + c); f32x4* xp = (f32x4*)(xr + c); *xp = *xp + g4 * acc[mt][nt]; } }
    }
}

__device__ __forceinline__ void ph_up_gemm(const Params& P, int l, int r0, int nrows, int wave, int lane) {
    const int gw = blockIdx.x * NWAVES + wave, NGW = gridDim.x * NWAVES;
    const int fr = lane & 15, fq = lane >> 4;
    const bf16_t* H = (const bf16_t*)(P.ws + WS_H); const bf16_t* W = wt_up(P, l); bf16_t* U = (bf16_t*)(P.ws + WS_U);
    const int nitems = (nrows / 32) * (NUP / 64);
    for (int it = gw; it < nitems; it += NGW) {
        const int rb = it / (NUP / 64), cb = it % (NUP / 64), row0 = r0 + rb * 32, c0 = cb * 64;
        const bf16_t* a0p = H + (size_t)(row0 + fr) * D + fq * 8; const bf16_t* a1p = a0p + (size_t)16 * D;
        const bf16_t* bp = W + (size_t)(c0 + fr) * D + fq * 8;
        f32x4 acc[2][4];
        wave_gemm(a0p, a1p, bp, bp + (size_t)16 * D, bp + (size_t)32 * D, bp + (size_t)48 * D, D, acc);
#pragma unroll
        for (int mt = 0; mt < 2; ++mt) { bf16_t* ur = U + (size_t)(row0 - r0 + 16 * mt + fr) * NUP + c0;
#pragma unroll
            for (int nt = 0; nt < 4; ++nt) { u32x2 w; w.x = pk2(acc[mt][nt].x, acc[mt][nt].y); w.y = pk2(acc[mt][nt].z, acc[mt][nt].w); *(u32x2*)(ur + 16 * nt + 4 * fq) = w; } }
    }
}

__device__ __forceinline__ void ph_conv(const Params& P, int l, int r0, int nrows) {
    const int gt = blockIdx.x * NTHREADS + threadIdx.x, NGT = gridDim.x * NTHREADS;
    const bf16_t* U = (const bf16_t*)(P.ws + WS_U); bf16_t* ACT = (bf16_t*)(P.ws + WS_ACT);
    const float* cw = P.in[23] + (size_t)l * 3 * NUP; const float* cb = P.in[24] + (size_t)l * NUP;
    const int per_row = DFF / 8;
    for (int i = gt; i < nrows * per_row; i += NGT) {
        const int rr = i / per_row, c = (i % per_row) * 8, row = r0 + rr;
        const int pos = row < MLAT ? (row & 4095) : ((row - MLAT) & 255), slen = row < MLAT ? SEQ : CTX;
        const int pa = 256 * (c >> 7) + (c & 127);
        float av[8], gv[8];
#pragma unroll
        for (int e = 0; e < 8; ++e) { av[e] = cb[c + e]; gv[e] = cb[DFF + c + e]; }
#pragma unroll
        for (int tap = 0; tap < 3; ++tap) {
            const int pp = pos + tap - 1;
            if (pp < 0 || pp >= slen) continue;
            const bf16_t* ur = U + (size_t)(rr + tap - 1) * NUP + pa;
            const u32x4 ua = *(const u32x4*)ur, ug = *(const u32x4*)(ur + 128);
            const float* wa = cw + tap * NUP + c; const float* wg = wa + DFF;
            av[0] += wa[0] * bf_lo(ua.x); av[1] += wa[1] * bf_hi(ua.x); av[2] += wa[2] * bf_lo(ua.y); av[3] += wa[3] * bf_hi(ua.y);
            av[4] += wa[4] * bf_lo(ua.z); av[5] += wa[5] * bf_hi(ua.z); av[6] += wa[6] * bf_lo(ua.w); av[7] += wa[7] * bf_hi(ua.w);
            gv[0] += wg[0] * bf_lo(ug.x); gv[1] += wg[1] * bf_hi(ug.x); gv[2] += wg[2] * bf_lo(ug.y); gv[3] += wg[3] * bf_hi(ug.y);
            gv[4] += wg[4] * bf_lo(ug.z); gv[5] += wg[5] * bf_hi(ug.z); gv[6] += wg[6] * bf_lo(ug.w); gv[7] += wg[7] * bf_hi(ug.w);
        }
        u32x4 o;
        o.x = pk2(av[0] * silu_f(gv[0]), av[1] * silu_f(gv[1])); o.y = pk2(av[2] * silu_f(gv[2]), av[3] * silu_f(gv[3]));
        o.z = pk2(av[4] * silu_f(gv[4]), av[5] * silu_f(gv[5])); o.w = pk2(av[6] * silu_f(gv[6]), av[7] * silu_f(gv[7]));
        *(u32x4*)(ACT + (size_t)row * DFF + c) = o;
    }
}

__device__ __forceinline__ void attn_key(const bf16_t* kp, const bf16_t* vp, const unsigned (&q)[32], float (&o)[64], float& m, float& l, bool valid, float bias) {
    float s0 = 0.f, s1 = 0.f;
#pragma unroll
    for (int c = 0; c < 8; ++c) { const u32x4 kk = *(const u32x4*)(kp + 8 * c);
        s0 += bf_lo(q[4 * c + 0]) * bf_lo(kk.x); s1 += bf_hi(q[4 * c + 0]) * bf_hi(kk.x); s0 += bf_lo(q[4 * c + 1]) * bf_lo(kk.y); s1 += bf_hi(q[4 * c + 1]) * bf_hi(kk.y);
        s0 += bf_lo(q[4 * c + 2]) * bf_lo(kk.z); s1 += bf_hi(q[4 * c + 2]) * bf_hi(kk.z); s0 += bf_lo(q[4 * c + 3]) * bf_lo(kk.w); s1 += bf_hi(q[4 * c + 3]) * bf_hi(kk.w); }
    float s = (s0 + s1) + bias; if (!valid) s = -1e30f;
    const float mn = fmaxf(m, s), a = __builtin_amdgcn_exp2f(m - mn), p = __builtin_amdgcn_exp2f(s - mn);
    l = l * a + p; m = mn;
#pragma unroll
    for (int c = 0; c < 8; ++c) { const u32x4 vv = *(const u32x4*)(vp + 8 * c);
        o[8 * c + 0] = o[8 * c + 0] * a + p * bf_lo(vv.x); o[8 * c + 1] = o[8 * c + 1] * a + p * bf_hi(vv.x); o[8 * c + 2] = o[8 * c + 2] * a + p * bf_lo(vv.y); o[8 * c + 3] = o[8 * c + 3] * a + p * bf_hi(vv.y);
        o[8 * c + 4] = o[8 * c + 4] * a + p * bf_lo(vv.z); o[8 * c + 5] = o[8 * c + 5] * a + p * bf_hi(vv.z); o[8 * c + 6] = o[8 * c + 6] * a + p * bf_lo(vv.w); o[8 * c + 7] = o[8 * c + 7] * a + p * bf_hi(vv.w); }
}

__device__ __forceinline__ void ph_attn(const Params& P, int l, int wave, int lane) {
    const int gw = blockIdx.x * NWAVES + wave, NGW = gridDim.x * NWAVES;
    const int kind = kind_of(l), kvw = kvw_of(l);
    const bool last = (l == DEPTH - 1);
    const LayerW lw = layer_w(P, l);
    const bf16_t* Qb = (const bf16_t*)(P.ws + WS_Q); const bf16_t* Kb = (const bf16_t*)(P.ws + WS_K); const bf16_t* Vb = (const bf16_t*)(P.ws + WS_V);
    bf16_t* Ob = (bf16_t*)(P.ws + WS_O);
    const int nrows = last ? MLAT : MTOT;
    const int nitems = (nrows / 64) * NH;
    for (int it = gw; it < nitems; it += NGW) {
        const int h = it & 15, rblk = it >> 4, row0 = rblk * 64, row = row0 + lane;
        const bool isctx = row0 >= MLAT;
        const int b = isctx ? ((row0 - MLAT) >> 8) : (row0 >> 12);
        const int kvh = kind == 0 ? h : (h >> 2);
        const bf16_t* Kbase = Kb + (size_t)b * KVROWS * kvw + kvh * 64; const bf16_t* Vbase = Vb + (size_t)b * KVROWS * kvw + kvh * 64;
        unsigned q[32]; float o[64];
        { const bf16_t* qp = Qb + (size_t)row * D + h * 64;
#pragma unroll
          for (int c = 0; c < 8; ++c) { const u32x4 w = *(const u32x4*)(qp + 8 * c); q[4 * c + 0] = w.x; q[4 * c + 1] = w.y; q[4 * c + 2] = w.z; q[4 * c + 3] = w.w; } }
#pragma unroll
        for (int d = 0; d < 64; ++d) o[d] = 0.f;
        float m = -1e30f, lsum = 0.f;
        for (int j = SEQ; j < KVROWS; ++j) attn_key(Kbase + (size_t)j * kvw, Vbase + (size_t)j * kvw, q, o, m, lsum, true, 0.f);
        if (!isctx) {
            const int t0 = row0 & 4095, t = t0 + lane;
            if (kind == 2) {
                for (int j = 0; j < SEQ; ++j) attn_key(Kbase + (size_t)j * kvw, Vbase + (size_t)j * kvw, q, o, m, lsum, true, 0.f);
            } else if (kind == 1) {
                const int jlo = t0 - 128 < 0 ? 0 : t0 - 128, jhi = t0 + 64 + 128 > SEQ ? SEQ : t0 + 64 + 128;
                for (int j = jlo; j < jhi; ++j) { const int dd = j - t; attn_key(Kbase + (size_t)j * kvw, Vbase + (size_t)j * kvw, q, o, m, lsum, dd >= -128 && dd <= 128, 0.f); }
            } else {
                const int r = t0 >> 6, c = lane;
                int rs = r - 4; rs = rs < 0 ? 0 : (rs > 56 ? 56 : rs);
                int cs = c - 8; cs = cs < 0 ? 0 : (cs > 48 ? 48 : cs);
                const float* rp = lw.rpb + (size_t)h * 15 * 31;
                for (int kr = rs; kr < rs + 8; ++kr) {
                    const float* rrow = rp + (kr - r + 7) * 31;
                    for (int kc = 0; kc < 64; ++kc) {
                        const bool valid = (kc >= cs) && (kc < cs + 16);
                        int dc = kc - c; dc = dc < -15 ? -15 : (dc > 15 ? 15 : dc);
                        const float bias = rrow[dc + 15] * LOG2E;
                        const int j = kr * 64 + kc;
                        attn_key(Kbase + (size_t)j * kvw, Vbase + (size_t)j * kvw, q, o, m, lsum, valid, bias);
                    }
                }
            }
        }
        if (kind == 1) lsum += __builtin_amdgcn_exp2f(lw.sink[h] * LOG2E - m);
        const float inv = 1.0f / lsum;
        bf16_t* op = Ob + (size_t)row * D + h * 64;
#pragma unroll
        for (int c = 0; c < 8; ++c) { u32x4 w; w.x = pk2(o[8 * c + 0] * inv, o[8 * c + 1] * inv); w.y = pk2(o[8 * c + 2] * inv, o[8 * c + 3] * inv); w.z = pk2(o[8 * c + 4] * inv, o[8 * c + 5] * inv); w.w = pk2(o[8 * c + 6] * inv, o[8 * c + 7] * inv);
            *(u32x4*)(op + 8 * c) = w; }
    }
}

namespace pg8 {
#define PG8_LAS __attribute__((address_space(3)))
typedef unsigned short bf16_t;
typedef short bf16x8 __attribute__((ext_vector_type(8)));
typedef float f32x4 __attribute__((ext_vector_type(4)));
typedef unsigned u32x4 __attribute__((ext_vector_type(4)));
constexpr int BM = 256, BK = 64, HALF = 128, HTB = HALF * BK * 2  , STAGE_BYTES = 8 * HTB, NXCD = 8, WGM = 8;

__host__ __device__ __forceinline__ int lds_byte(int r, int c) { const int st = (r >> 4) * 2 + (c >> 5), rr = r & 15, cc = c & 31, ob = rr * 64 + cc * 2; return st * 1024 + (ob ^ (((ob >> 9) & 1) << 5)); }
__host__ __device__ __forceinline__ void stage_rc(int b, int& R, int& C) { const int st = b / 1024, sb = b % 1024, swz = sb ^ (((sb >> 9) & 1) << 5); R = (st >> 1) * 16 + swz / 64; C = (st & 1) * 32 + (swz % 64) / 2; }
__host__ __device__ __forceinline__ int perm32(int rho) { const int n = rho >> 4, i = rho & 15; return 8 * (i >> 2) + 4 * n + (i & 3); }

struct Unit { int pm, pn; };
struct Gemm { const bf16_t* A; const bf16_t* Bt; int M, N, K; };

struct StaticOrder {
    int nM, nN, nwg, G, c;
    __host__ __device__ void init(int M, int N, int G_, int c_) { nM = M / BM; nN = N / BM; nwg = nM * nN; G = G_; c = c_; }
    __host__ __device__ bool next(int i, Unit& u) const {
        const long L = (long)i * G + c; if (L >= nwg) return false;
        int wgid = (int)L; { const int q = nwg / NXCD, r = nwg % NXCD, xcd = wgid % NXCD, off = wgid / NXCD; wgid = (xcd < r ? xcd * (q + 1) : r * (q + 1) + (xcd - r) * q) + off; }
        const int nig = WGM * nN, gid = wgid / nig, fm = gid * WGM, gsz = (nM - fm) < WGM ? (nM - fm) : WGM;
        u.pm = fm + ((wgid % nig) % gsz); u.pn = (wgid % nig) / gsz; return true;
    }
    __device__ __forceinline__ void a_ready(const Unit&) const {}
    __device__ __forceinline__ void done(const Unit&) const {}
};
template <class Epi, class Sched, bool ALIGN_EPI = false, bool SP2 = false>
__device__ __forceinline__ void gemm_phase(PG8_LAS unsigned char* lds, const Gemm g, const Sched& S, const Epi& E) {
    const int tid = tid_opaque(), wid = __builtin_amdgcn_readfirstlane(tid >> 6), lane = tid & 63, wr = wid >> 2, wc = wid & 3, fr = lane & 15, fq = lane >> 4;
    const int K = g.K, nt = K / BK;
    unsigned voffA[2], voffB[2];
#pragma unroll
    for (int i = 0; i < 2; ++i) { int R, C; stage_rc(tid * 16 + i * 8192, R, C); const int Rb = Epi::PERM ? ((R & ~31) + perm32(R & 31)) : R;
        voffA[i] = (unsigned)(R * K + C) * 2u; voffB[i] = (unsigned)(Rb * K + C) * 2u; }
    const size_t kstep = (size_t)(BK * 2);
    const size_t hstep = (size_t)HALF * K * 2;
    const size_t tstep = 2 * hstep;
    const unsigned ldsw = (unsigned)wid * 1024u;
    const int aoff = lds_byte(wr * 64 + fr, fq * 8), boff = lds_byte(wc * 32 + fr, fq * 8);
#define PG8_SA(b, h) (((b) * 2 + (h)) * HTB)
#define PG8_SB(b, h) ((4 + (b) * 2 + (h)) * HTB)
#define PG8_STAGE(bufoff, gbase, voff) do { _Pragma("unroll") for (int _i = 0; _i < 2; ++_i) \
        __builtin_amdgcn_global_load_lds((const unsigned*)((const char*)(gbase) + (voff)[_i]), (PG8_LAS unsigned*)(lds + (bufoff) + ldsw + _i * 8192), 16, 0, 0); } while (0)
#define PG8_LDA(dst, b, h) do { _Pragma("unroll") for (int m = 0; m < 4; ++m) _Pragma("unroll") for (int k = 0; k < 2; ++k) dst[m][k] = *(const PG8_LAS bf16x8*)(lds + PG8_SA(b, h) + aoff + m * 2048 + k * 1024); } while (0)
#define PG8_LDB(dst, b, h) do { _Pragma("unroll") for (int n = 0; n < 2; ++n) _Pragma("unroll") for (int k = 0; k < 2; ++k) dst[n][k] = *(const PG8_LAS bf16x8*)(lds + PG8_SB(b, h) + boff + n * 2048 + k * 1024); } while (0)
#define PG8_MMA(ai, bj, At, Bt) do { __builtin_amdgcn_s_setprio(1); _Pragma("unroll") for (int m = 0; m < 4; ++m) _Pragma("unroll") for (int n = 0; n < 2; ++n) _Pragma("unroll") for (int k = 0; k < 2; ++k) \
        acc[ai][bj][m][n] = __builtin_amdgcn_mfma_f32_16x16x32_bf16(Bt[n][k], At[m][k], acc[ai][bj][m][n], 0, 0, 0); __builtin_amdgcn_s_setprio(0); } while (0)
#define PG8_WAIT_V(n) asm volatile("s_waitcnt vmcnt(" #n ")" ::: "memory")
#define PG8_WAIT_L(n) asm volatile("s_waitcnt lgkmcnt(" #n ")" ::: "memory")
#define PG8_BAR __builtin_amdgcn_s_barrier()
#define PG8_SCHED __builtin_amdgcn_sched_barrier(0)
    Unit cur, nxt; int ui = 0;
    if (!S.next(0, cur)) return;
    f32x4 acc[2][2][4][2];
#pragma unroll
    for (int a = 0; a < 2; ++a)
#pragma unroll
        for (int b = 0; b < 2; ++b)
#pragma unroll
            for (int m = 0; m < 4; ++m)
#pragma unroll
                for (int n = 0; n < 2; ++n) acc[a][b][m][n] = (f32x4){0.f, 0.f, 0.f, 0.f};
    bf16x8 At[4][2], B0[2][2], B1[2][2];
    const char* cA = (const char*)g.A + (size_t)cur.pm * tstep; const char* cB = (const char*)g.Bt + (size_t)cur.pn * tstep;
    S.a_ready(cur);
    if constexpr (SP2) {
        PG8_STAGE(PG8_SB(0, 0), cB, voffB); PG8_STAGE(PG8_SB(0, 1), cB + hstep, voffB); PG8_STAGE(PG8_SA(0, 0), cA, voffA); PG8_STAGE(PG8_SA(0, 1), cA + hstep, voffA);
        if (wr == 1) PG8_BAR;
        PG8_WAIT_V(2); PG8_BAR;
        PG8_STAGE(PG8_SB(1, 0), cB + kstep, voffB); PG8_STAGE(PG8_SA(1, 0), cA + kstep, voffA); PG8_STAGE(PG8_SB(1, 1), cB + hstep + kstep, voffB);
        PG8_WAIT_V(6); PG8_BAR;
    } else {
        PG8_STAGE(PG8_SB(0, 0), cB, voffB); PG8_STAGE(PG8_SA(0, 0), cA, voffA); PG8_STAGE(PG8_SB(0, 1), cB + hstep, voffB); PG8_STAGE(PG8_SA(0, 1), cA + hstep, voffA);
        if (wr == 1) PG8_BAR;
        PG8_WAIT_V(4); PG8_BAR;
        PG8_STAGE(PG8_SB(1, 0), cB + kstep, voffB); PG8_STAGE(PG8_SA(1, 0), cA + kstep, voffA); PG8_STAGE(PG8_SB(1, 1), cB + hstep + kstep, voffB);
        PG8_WAIT_V(6); PG8_BAR;
    }
    for (;;) {
        const bool has_next = S.next(ui + 1, nxt);
        const char* nA = has_next ? (const char*)g.A + (size_t)nxt.pm * tstep : cA; const char* nB = has_next ? (const char*)g.Bt + (size_t)nxt.pn * tstep : cB;
        for (int t = 0; t < nt; t += 2) {
            const bool last = (t == nt - 2);
            const char* a1 = cA + (size_t)(t + 1) * kstep;
            const char* a2 = last ? nA : cA + (size_t)(t + 2) * kstep; const char* b2 = last ? nB : cB + (size_t)(t + 2) * kstep;
            const char* a3 = a2 + kstep; const char* b3 = b2 + kstep;
            if (last && has_next) S.a_ready(nxt);
            if constexpr (SP2) {
            PG8_LDB(B0, 0, 0); PG8_LDB(B1, 0, 1); PG8_SCHED; PG8_LDA(At, 0, 0); PG8_STAGE(PG8_SA(1, 1), a1 + hstep, voffA);
            PG8_WAIT_V(8); PG8_WAIT_L(0); PG8_BAR; PG8_MMA(0, 0, At, B0); PG8_MMA(0, 1, At, B1); PG8_BAR; PG8_SCHED;
            PG8_LDA(At, 0, 1); PG8_STAGE(PG8_SB(0, 0), b2, voffB); PG8_STAGE(PG8_SB(0, 1), b2 + hstep, voffB); PG8_STAGE(PG8_SA(0, 0), a2, voffA);
            PG8_WAIT_V(8); PG8_WAIT_L(0); PG8_BAR; PG8_MMA(1, 0, At, B0); PG8_MMA(1, 1, At, B1); PG8_BAR; PG8_SCHED;
            PG8_LDB(B0, 1, 0); PG8_LDB(B1, 1, 1); PG8_SCHED; PG8_LDA(At, 1, 0); PG8_STAGE(PG8_SA(0, 1), a2 + hstep, voffA);
            PG8_WAIT_V(8); PG8_WAIT_L(0); PG8_BAR; PG8_MMA(0, 0, At, B0); PG8_MMA(0, 1, At, B1); PG8_BAR; PG8_SCHED;
            PG8_LDA(At, 1, 1); PG8_STAGE(PG8_SB(1, 0), b3, voffB); PG8_STAGE(PG8_SB(1, 1), b3 + hstep, voffB); PG8_STAGE(PG8_SA(1, 0), a3, voffA);
            PG8_WAIT_V(8); PG8_WAIT_L(0); PG8_BAR; PG8_MMA(1, 0, At, B0); PG8_MMA(1, 1, At, B1); PG8_BAR; PG8_SCHED;
            } else {
            PG8_LDB(B0, 0, 0); PG8_SCHED; PG8_LDA(At, 0, 0); PG8_STAGE(PG8_SA(1, 1), a1 + hstep, voffA);
            PG8_WAIT_L(8); PG8_BAR; PG8_WAIT_L(0); PG8_MMA(0, 0, At, B0); PG8_BAR; PG8_SCHED;
            PG8_LDB(B1, 0, 1); PG8_STAGE(PG8_SB(0, 0), b2, voffB);
            PG8_BAR; PG8_WAIT_L(0); PG8_MMA(0, 1, At, B1); PG8_BAR;
            PG8_LDA(At, 0, 1); PG8_STAGE(PG8_SA(0, 0), a2, voffA);
            PG8_BAR; PG8_WAIT_L(0); PG8_MMA(1, 0, At, B0); PG8_BAR; PG8_SCHED;
            PG8_STAGE(PG8_SB(0, 1), b2 + hstep, voffB);
            PG8_WAIT_V(6); PG8_BAR; PG8_MMA(1, 1, At, B1); PG8_BAR;
            PG8_LDB(B0, 1, 0); PG8_SCHED; PG8_LDA(At, 1, 0); PG8_STAGE(PG8_SA(0, 1), a2 + hstep, voffA);
            PG8_WAIT_L(8); PG8_BAR; PG8_WAIT_L(0); PG8_MMA(0, 0, At, B0); PG8_BAR; PG8_SCHED;
            PG8_LDB(B1, 1, 1); PG8_STAGE(PG8_SB(1, 0), b3, voffB);
            PG8_BAR; PG8_WAIT_L(0); PG8_MMA(0, 1, At, B1); PG8_BAR;
            PG8_LDA(At, 1, 1); PG8_STAGE(PG8_SA(1, 0), a3, voffA);
            PG8_BAR; PG8_WAIT_L(0); PG8_MMA(1, 0, At, B0); PG8_BAR; PG8_SCHED;
            PG8_STAGE(PG8_SB(1, 1), b3 + hstep, voffB);
            PG8_WAIT_V(6); PG8_BAR; PG8_MMA(1, 1, At, B1); PG8_BAR;
            }
        }
        if constexpr (ALIGN_EPI) { if (wr == 0) PG8_BAR; }
        if constexpr (!Epi::AFTER_DRAIN) { E(acc, cur, wr, wc, fr, fq); S.done(cur); }
        if (!has_next) break;
#pragma unroll
        for (int a = 0; a < 2; ++a)
#pragma unroll
            for (int b = 0; b < 2; ++b)
#pragma unroll
                for (int m = 0; m < 4; ++m)
#pragma unroll
                    for (int n = 0; n < 2; ++n) acc[a][b][m][n] = (f32x4){0.f, 0.f, 0.f, 0.f};
        cur = nxt; cA = nA; cB = nB; ++ui;
        if constexpr (ALIGN_EPI) { if (wr == 1) PG8_BAR; }
    }
    PG8_WAIT_V(0);
    if constexpr (!ALIGN_EPI) { if (wr == 0) PG8_BAR; }
    PG8_BAR;
    if constexpr (Epi::AFTER_DRAIN) { E.fused(acc, cur, wr, wc, fr, fq, lds, wid, lane); S.done(cur); }
#undef PG8_SA
#undef PG8_SB
#undef PG8_STAGE
#undef PG8_LDA
#undef PG8_LDB
#undef PG8_MMA
#undef PG8_WAIT_V
#undef PG8_WAIT_L
#undef PG8_BAR
#undef PG8_SCHED
}
}

#ifndef PG8_SP2
#define PG8_SP2 true
#endif
#ifndef PG8_ALIGN
#define PG8_ALIGN true
#endif

__device__ __forceinline__ unsigned cvt_pk_bf16(float lo, float hi) { unsigned r; asm volatile("v_cvt_pk_bf16_f32 %0, %1, %2" : "=v"(r) : "v"(lo), "v"(hi)); return r; }


__device__ __forceinline__ void row_rstd(const float* stats, int row0, int fq, float (&rstd)[2][4]) {
#pragma unroll
    for (int ai = 0; ai < 2; ++ai) {
        f32x4 p[4];
#pragma unroll
        for (int m = 0; m < 4; ++m) p[m] = *(const f32x4*)(stats + (size_t)(row0 + 128 * ai + 16 * m) * 16 + 4 * fq);
#pragma unroll
        for (int m = 0; m < 4; ++m) { float s = (p[m].x + p[m].y) + (p[m].z + p[m].w); s += __shfl_xor(s, 16); s += __shfl_xor(s, 32);
            rstd[ai][m] = 1.0f / sqrtf(s * (1.f / D) + RMS_EPS); }
        asm volatile("" ::: "memory");
    }
}

template <int L> struct EpiQKV {
    static constexpr bool PERM = true, AFTER_DRAIN = false;
    bf16_t *Q, *K, *V; const float *gq, *gk, *rope, *stats, *bias;
    __device__ __forceinline__ void operator()(const f32x4 (&acc)[2][2][4][2], const pg8::Unit& u, int wr, int wc, int fr, int fq) const {
        constexpr int kind = kind_of(L), kvw = kvw_of(L), nkvh = kvw / 64; constexpr bool last = (L == DEPTH - 1);
        const int hh = 4 * u.pn + wc;
        const int type = hh < 16 ? 0 : (hh < 16 + nkvh ? 1 : 2);
        const int hidx = type == 0 ? hh : (type == 1 ? hh - 16 : hh - 16 - nkvh);
        if (last && u.pm >= 64 && type == 0) return;
        const float* gg = type == 0 ? gq : gk;
        f32x4 g4[2][2], b4[2][2];
        const int ci = u.pm < 64 ? (u.pm >> 4) : 4;
        const float* bp = bias + (size_t)ci * nqkv_of(L) + 256 * u.pn + 32 * wc + 8 * fq;
#pragma unroll
        for (int bj = 0; bj < 2; ++bj)
#pragma unroll
            for (int n = 0; n < 2; ++n) { g4[bj][n] = *(const f32x4*)(gg + 32 * bj + 8 * fq + 4 * n); b4[bj][n] = *(const f32x4*)(bp + 128 * bj + 4 * n); }
        float rstd[2][4];
        row_rstd(stats, 256 * u.pm + 64 * wr + fr, fq, rstd);
#pragma unroll
        for (int ai = 0; ai < 2; ++ai)
#pragma unroll
            for (int m = 0; m < 4; ++m) {
                const int row = 256 * u.pm + 128 * ai + 64 * wr + 16 * m + fr;
                f32x4 v[2][2];
#pragma unroll
                for (int bj = 0; bj < 2; ++bj)
#pragma unroll
                    for (int n = 0; n < 2; ++n) v[bj][n] = acc[ai][bj][m][n] * rstd[ai][m] + b4[bj][n];
                if (type < 2) {
                    float ss = 0.f;
#pragma unroll
                    for (int bj = 0; bj < 2; ++bj)
#pragma unroll
                        for (int n = 0; n < 2; ++n) ss += (v[bj][n].x * v[bj][n].x + v[bj][n].y * v[bj][n].y) + (v[bj][n].z * v[bj][n].z + v[bj][n].w * v[bj][n].w);
                    ss += __shfl_xor(ss, 16); ss += __shfl_xor(ss, 32);
                    const float rinv = 1.0f / sqrtf(ss * (1.f / 64.f) + RMS_EPS);
#pragma unroll
                    for (int bj = 0; bj < 2; ++bj)
#pragma unroll
                        for (int n = 0; n < 2; ++n) v[bj][n] = (v[bj][n] * rinv) * g4[bj][n];
                    if (kind != 0 && u.pm < 64) {
                        const int t = row & 4095, pos = fq < 2 ? (t >> 6) : (t & 63);
#pragma unroll
                        for (int n = 0; n < 2; ++n) {
                            const float* tb = rope + (pos * 16 + 8 * (fq & 1) + 4 * n) * 2;
                            const f32x4 t0 = *(const f32x4*)tb, t1 = *(const f32x4*)(tb + 4);
                            const f32x4 cs = (f32x4){t0.x, t0.z, t1.x, t1.z}, sn = (f32x4){t0.y, t0.w, t1.y, t1.w};
                            const f32x4 x1 = v[0][n], x2 = v[1][n];
                            v[0][n] = x1 * cs - x2 * sn; v[1][n] = x2 * cs + x1 * sn;
                        }
                    }
                    if (type == 0) {
#pragma unroll
                        for (int bj = 0; bj < 2; ++bj)
#pragma unroll
                            for (int n = 0; n < 2; ++n) v[bj][n] = v[bj][n] * C2;
                    }
                }
                bf16_t* dst;
                if (type == 0) dst = Q + (size_t)row * D + hidx * 64;
                else dst = (type == 1 ? K : V) + kv_row(row) * kvw + hidx * 64;
#pragma unroll
                for (int bj = 0; bj < 2; ++bj) { u32x4 w; w.x = cvt_pk_bf16(v[bj][0].x, v[bj][0].y); w.y = cvt_pk_bf16(v[bj][0].z, v[bj][0].w); w.z = cvt_pk_bf16(v[bj][1].x, v[bj][1].y); w.w = cvt_pk_bf16(v[bj][1].z, v[bj][1].w);
                    *(u32x4*)(dst + 32 * bj + 8 * fq) = w; }
            }
    }
};

struct EpiResid {
    static constexpr bool PERM = true, AFTER_DRAIN = false;
    float* lat; float* ctx; const float* gate_l;
    bf16_t* H; float* stats; const float* gn; const float* scn;
    __device__ __forceinline__ void operator()(const f32x4 (&acc)[2][2][4][2], const pg8::Unit& u, int wr, int wc, int fr, int fq) const {
        const int ci = u.pm < 64 ? (u.pm >> 4) : 4;
        const int lcol = 32 * wc + 8 * fq;
        const int loff = (64 * wr + fr) * D + lcol;
        const float* gate = gate_l + (size_t)ci * 6144 + 256 * u.pn;
        float* xbu = (u.pm < 64 ? lat + (size_t)(256 * u.pm) * D : ctx + (size_t)(256 * (u.pm - 64)) * D) + 256 * u.pn;
        bf16_t* hbu = H + (size_t)(256 * u.pm) * D + 256 * u.pn;
        const bool emit = gn != nullptr;
        const float* gnu = gn + 256 * u.pn; const float* scu = scn + (size_t)ci * 6144 + 256 * u.pn;
        float ss[2][4];
#pragma unroll
        for (int ai = 0; ai < 2; ++ai)
#pragma unroll
            for (int m = 0; m < 4; ++m) ss[ai][m] = 0.f;
#pragma unroll
        for (int bj = 0; bj < 2; ++bj) {
            f32x4 g4[2], G4[2];
#pragma unroll
            for (int n = 0; n < 2; ++n) { g4[n] = *(const f32x4*)((gate + 128 * bj + 4 * n) + lcol);
                if (emit) G4[n] = *(const f32x4*)((gnu + 128 * bj + 4 * n) + lcol) * (*(const f32x4*)((scu + 128 * bj + 4 * n) + lcol) + 1.0f);
                else G4[n] = (f32x4){0.f, 0.f, 0.f, 0.f}; }
#pragma unroll
            for (int ai = 0; ai < 2; ++ai) {
                f32x4 xl[4][2];
#pragma unroll
                for (int m = 0; m < 4; ++m)
#pragma unroll
                    for (int n = 0; n < 2; ++n) xl[m][n] = *(const f32x4*)((xbu + (128 * ai + 16 * m) * D + 128 * bj + 4 * n) + loff);
                asm volatile("" ::: "memory");
#pragma unroll
                for (int m = 0; m < 4; ++m) { f32x4 xn[2];
#pragma unroll
                    for (int n = 0; n < 2; ++n) { xn[n] = xl[m][n] + g4[n] * acc[ai][bj][m][n]; *(f32x4*)((xbu + (128 * ai + 16 * m) * D + 128 * bj + 4 * n) + loff) = xn[n];
                        ss[ai][m] += (xn[n].x * xn[n].x + xn[n].y * xn[n].y) + (xn[n].z * xn[n].z + xn[n].w * xn[n].w); }
                    if (emit) { const f32x4 h0 = xn[0] * G4[0], h1 = xn[1] * G4[1];
                        u32x4 w; w.x = cvt_pk_bf16(h0.x, h0.y); w.y = cvt_pk_bf16(h0.z, h0.w); w.z = cvt_pk_bf16(h1.x, h1.y); w.w = cvt_pk_bf16(h1.z, h1.w);
                        *(u32x4*)((hbu + (128 * ai + 16 * m) * D + 128 * bj) + loff) = w; } }
                asm volatile("" ::: "memory");
            }
        }
        if (emit) {
            float* stu = stats + (size_t)(256 * u.pm) * 16 + 4 * u.pn + wc;
#pragma unroll
            for (int ai = 0; ai < 2; ++ai)
#pragma unroll
                for (int m = 0; m < 4; ++m) { float t = ss[ai][m]; t += __shfl_xor(t, 16); t += __shfl_xor(t, 32);
                    if (fq == 0) (stu + (128 * ai + 16 * m) * 16)[(64 * wr + fr) * 16] = t; }
        }
    }
};

struct EpiStore {
    static constexpr bool PERM = true, AFTER_DRAIN = false;
    bf16_t* O; int ldc;
    __device__ __forceinline__ void operator()(const f32x4 (&acc)[2][2][4][2], const pg8::Unit& u, int wr, int wc, int fr, int fq) const {
        bf16_t* base = O + (size_t)(256 * u.pm + 64 * wr + fr) * ldc + 256 * u.pn + 32 * wc + 8 * fq;
#pragma unroll
        for (int ai = 0; ai < 2; ++ai)
#pragma unroll
            for (int m = 0; m < 4; ++m) { bf16_t* rowp = base + (size_t)(128 * ai + 16 * m) * ldc;
#pragma unroll
                for (int bj = 0; bj < 2; ++bj) { const f32x4 v0 = acc[ai][bj][m][0], v1 = acc[ai][bj][m][1];
                    u32x4 w; w.x = cvt_pk_bf16(v0.x, v0.y); w.y = cvt_pk_bf16(v0.z, v0.w); w.z = cvt_pk_bf16(v1.x, v1.y); w.w = cvt_pk_bf16(v1.z, v1.w);
                    *(u32x4*)(rowp + 128 * bj) = w; } }
    }
};


__device__ __forceinline__ float dpp_up(float cur, float prevblk) {
    const int old = __builtin_amdgcn_update_dpp(0, __builtin_bit_cast(int, prevblk), 0x121  , 0xf, 0xf, true);
    return __builtin_bit_cast(float, __builtin_amdgcn_update_dpp(old, __builtin_bit_cast(int, cur), 0x111  , 0xf, 0xf, false));
}
__device__ __forceinline__ float dpp_dn(float cur, float nextblk) {
    const int old = __builtin_amdgcn_update_dpp(0, __builtin_bit_cast(int, nextblk), 0x12F  , 0xf, 0xf, true);
    return __builtin_bit_cast(float, __builtin_amdgcn_update_dpp(old, __builtin_bit_cast(int, cur), 0x101  , 0xf, 0xf, false));
}
struct EpiUpConv {
    static constexpr bool PERM = true, AFTER_DRAIN = false;
    bf16_t* ACT; float* HB; const float* cw; const float* cb;
    const float* stats; const float* bias;
    __device__ __forceinline__ void operator()(f32x4 (&acc)[2][2][4][2], const pg8::Unit& u, int wr, int wc, int fr, int fq) const {
        const int ca = 128 * u.pn + 32 * wc + 8 * fq;
        { const int ci = u.pm < 64 ? (u.pm >> 4) : 4;
          const float* bp = bias + (size_t)ci * NUP + 256 * u.pn + 32 * wc + 8 * fq;
          float rstd[2][4];
          row_rstd(stats, 256 * u.pm + 64 * wr + fr, fq, rstd);
#pragma unroll
          for (int bj = 0; bj < 2; ++bj)
#pragma unroll
              for (int n = 0; n < 2; ++n) { const f32x4 b4 = *(const f32x4*)(bp + 128 * bj + 4 * n);
#pragma unroll
                  for (int ai = 0; ai < 2; ++ai)
#pragma unroll
                      for (int m = 0; m < 4; ++m) acc[ai][bj][m][n] = acc[ai][bj][m][n] * rstd[ai][m] + b4; } }
        unsigned outp[2][4][2][2];
#pragma unroll
        for (int n = 0; n < 2; ++n) {
            f32x4 wa[3], wg[3];
#pragma unroll
            for (int tap = 0; tap < 3; ++tap) { wa[tap] = *(const f32x4*)(cw + tap * NUP + ca + 4 * n); wg[tap] = *(const f32x4*)(cw + tap * NUP + DFF + ca + 4 * n); }
            const f32x4 ba = *(const f32x4*)(cb + ca + 4 * n), bg = *(const f32x4*)(cb + DFF + ca + 4 * n);
#pragma unroll
            for (int ai = 0; ai < 2; ++ai)
#pragma unroll
                for (int m = 0; m < 4; ++m) {
                    const f32x4 z = (f32x4){0.f, 0.f, 0.f, 0.f};
                    const f32x4 A = acc[ai][0][m][n], G = acc[ai][1][m][n];
                    const f32x4 Ap = m > 0 ? acc[ai][0][m - 1][n] : z, An = m < 3 ? acc[ai][0][m + 1][n] : z;
                    const f32x4 Gp = m > 0 ? acc[ai][1][m - 1][n] : z, Gn = m < 3 ? acc[ai][1][m + 1][n] : z;
                    float r[4];
#pragma unroll
                    for (int i = 0; i < 4; ++i) {
                        const float av = ba[i] + wa[0][i] * dpp_up(A[i], Ap[i]) + wa[1][i] * A[i] + wa[2][i] * dpp_dn(A[i], An[i]);
                        const float gv = bg[i] + wg[0][i] * dpp_up(G[i], Gp[i]) + wg[1][i] * G[i] + wg[2][i] * dpp_dn(G[i], Gn[i]);
                        r[i] = av * gv * __builtin_amdgcn_rcpf(1.0f + __builtin_amdgcn_exp2f(-LOG2E * gv));
                    }
                    outp[ai][m][n][0] = cvt_pk_bf16(r[0], r[1]); outp[ai][m][n][1] = cvt_pk_bf16(r[2], r[3]);
                }
        }
        const int row0 = 256 * u.pm + 64 * wr + fr;
#pragma unroll
        for (int ai = 0; ai < 2; ++ai)
#pragma unroll
            for (int m = 0; m < 4; ++m) { u32x4 w; w.x = outp[ai][m][0][0]; w.y = outp[ai][m][0][1]; w.z = outp[ai][m][1][0]; w.w = outp[ai][m][1][1];
                *(u32x4*)(ACT + (size_t)(row0 + 128 * ai + 16 * m) * DFF + ca) = w; }
        const int pc = 256 * u.pn + 32 * wc + 8 * fq;
#pragma unroll
        for (int ai = 0; ai < 2; ++ai) {
            const int grp = 4 * u.pm + 2 * ai + wr;
            if (fr < 2) { float* hb = HB + ((size_t)grp * 4 + fr) * NUP + pc;
#pragma unroll
                for (int bj = 0; bj < 2; ++bj)
#pragma unroll
                    for (int n = 0; n < 2; ++n) *(f32x4*)(hb + 128 * bj + 4 * n) = acc[ai][bj][0][n]; }
            if (fr >= 14) { float* hb = HB + ((size_t)grp * 4 + 2 + (fr - 14)) * NUP + pc;
#pragma unroll
                for (int bj = 0; bj < 2; ++bj)
#pragma unroll
                    for (int n = 0; n < 2; ++n) *(f32x4*)(hb + 128 * bj + 4 * n) = acc[ai][bj][3][n]; }
        }
    }
};
__device__ __forceinline__ void ph_upconv_fast(const Params& P, int l, LAS unsigned char* lds, int nrows) {
    pg8::Gemm g{(const bf16_t*)(P.ws + WS_H), wt_up(P, l), nrows, NUP, D};
    pg8::StaticOrder S; S.init(nrows, NUP, (int)gridDim.x, (int)blockIdx.x);
    EpiUpConv E{(bf16_t*)(P.ws + WS_ACT), (float*)(P.ws + WS_HB), P.in[23] + (size_t)l * 3 * NUP, P.in[24] + (size_t)l * NUP, (const float*)(P.ws + WS_STATS), (const float*)(P.ws + WS_BUP) + (size_t)l * 5 * NUP};
    pg8::gemm_phase<EpiUpConv, pg8::StaticOrder, PG8_ALIGN, PG8_SP2>(lds, g, S, E);
}
__device__ __forceinline__ void ph_fix(const Params& P, int l, int nrows) {
    const int gt = blockIdx.x * NTHREADS + tid_opaque(), NGT = gridDim.x * NTHREADS;
    const float* HB = (const float*)(P.ws + WS_HB); bf16_t* ACT = (bf16_t*)(P.ws + WS_ACT);
    const float* cw = P.in[23] + (size_t)l * 3 * NUP; const float* cb = P.in[24] + (size_t)l * NUP;
    const int per_row = DFF / 4, nitems = (nrows / 64) * 2 * per_row;
    for (int it = gt; it < nitems; it += NGT) {
        const int c = (it % per_row) * 4, ge = it / per_row, grp = ge >> 1, e = ge & 1;
        const int row = 64 * grp + (e ? 63 : 0);
        const int pos = row < MLAT ? (row & 4095) : ((row - MLAT) & 255), slen = row < MLAT ? SEQ : CTX;
        const int pa = 256 * (c >> 7) + (c & 127);
        const float* ctr = HB + ((size_t)grp * 4 + (e ? 3 : 0)) * NUP + pa;
        const float* upp = e ? HB + ((size_t)grp * 4 + 2) * NUP + pa : (pos > 0 ? HB + ((size_t)(grp - 1) * 4 + 3) * NUP + pa : nullptr);
        const float* dnp = e ? (pos < slen - 1 ? HB + ((size_t)(grp + 1) * 4 + 0) * NUP + pa : nullptr) : HB + ((size_t)grp * 4 + 1) * NUP + pa;
        f32x4 av = *(const f32x4*)(cb + c), gv = *(const f32x4*)(cb + DFF + c);
        av = av + *(const f32x4*)(cw + NUP + c) * *(const f32x4*)ctr; gv = gv + *(const f32x4*)(cw + NUP + DFF + c) * *(const f32x4*)(ctr + 128);
        if (upp) { av = av + *(const f32x4*)(cw + c) * *(const f32x4*)upp; gv = gv + *(const f32x4*)(cw + DFF + c) * *(const f32x4*)(upp + 128); }
        if (dnp) { av = av + *(const f32x4*)(cw + 2 * NUP + c) * *(const f32x4*)dnp; gv = gv + *(const f32x4*)(cw + 2 * NUP + DFF + c) * *(const f32x4*)(dnp + 128); }
        u32x2 o; o.x = pk2(av.x * silu_f(gv.x), av.y * silu_f(gv.y)); o.y = pk2(av.z * silu_f(gv.z), av.w * silu_f(gv.w));
        *(u32x2*)(ACT + (size_t)row * DFF + c) = o;
    }
}

template <int L> __device__ __forceinline__ void ph_qkv_fast(const Params& P, LAS unsigned char* lds) {
    const LayerW lw = layer_w(P, L);
    pg8::Gemm g{(const bf16_t*)(P.ws + WS_H), wt_qkv(P, L), MTOT, nqkv_of(L), D};
    pg8::StaticOrder S; S.init(MTOT, nqkv_of(L), (int)gridDim.x, (int)blockIdx.x);
    EpiQKV<L> E{(bf16_t*)(P.ws + WS_Q), (bf16_t*)(P.ws + WS_K), (bf16_t*)(P.ws + WS_V), lw.gq, lw.gk, (const float*)(P.ws + WS_ROPE), (const float*)(P.ws + WS_STATS), (const float*)(P.ws + WS_BQKV) + (size_t)L * 5 * 3072};
    pg8::gemm_phase<EpiQKV<L>, pg8::StaticOrder, PG8_ALIGN, PG8_SP2>(lds, g, S, E);
}
__device__ __forceinline__ void ph_resid_fast(const Params& P, int l, LAS unsigned char* lds, const bf16_t* A, int K, const bf16_t* W, int gate_off, int nrows, const float* gn, const float* scn, bool dummy = false) {
    pg8::Gemm g{A, W, nrows, D, K};
    pg8::StaticOrder S; S.init(nrows, D, (int)gridDim.x, (int)blockIdx.x);
    EpiResid E{dummy ? (float*)(P.ws + WS_K) : P.out, dummy ? (float*)(P.ws + WS_O) : (float*)(P.ws + WS_CTXRES), mod_ptr(P, l, 0) + gate_off, dummy ? (bf16_t*)(P.ws + WS_Q) : (bf16_t*)(P.ws + WS_H), dummy ? (float*)(P.ws + WS_O + 8 * MiB) : (float*)(P.ws + WS_STATS), gn, scn};
    pg8::gemm_phase<EpiResid, pg8::StaticOrder, PG8_ALIGN, PG8_SP2>(lds, g, S, E);
}
__device__ __forceinline__ void ph_up_fast(const Params& P, int l, LAS unsigned char* lds, int r0, int nrows) {
    pg8::Gemm g{(const bf16_t*)(P.ws + WS_H) + (size_t)r0 * D, wt_up(P, l), nrows, NUP, D};
    pg8::StaticOrder S; S.init(nrows, NUP, (int)gridDim.x, (int)blockIdx.x);
    EpiStore E{(bf16_t*)(P.ws + WS_U), NUP};
    pg8::gemm_phase<EpiStore, pg8::StaticOrder, PG8_ALIGN, PG8_SP2>(lds, g, S, E);
}

namespace att {
using s16x4 = __attribute__((ext_vector_type(4))) short;
using f32x16 = __attribute__((ext_vector_type(16))) float;
constexpr int NW = 8, QBLK = 32, QB = QBLK * NW, KVBLK = 64;
constexpr int NSLOT = 3, SLOTB = 8192;
constexpr int LDS_K = 0, LDS_V = NSLOT * SLOTB, LDS_WS = 2 * NSLOT * SLOTB, LDS_OST = LDS_WS + NW * 64 * 4, LDS_BIAS = LDS_OST + NW * 4096, LDS_BYTES = LDS_BIAS + 2048;
#define SBAR() __builtin_amdgcn_sched_barrier(0)
__device__ __forceinline__ int crow(int r, int hi) { return (r & 3) + 8 * (r >> 2) + 4 * hi; }
__device__ __forceinline__ void glds16(const void* gsrc, unsigned lds_dst) { unsigned keep;
    asm volatile("s_mov_b32 %0, m0\n\ts_mov_b32 m0, %2\n\ts_nop 0\n\tglobal_load_lds_dwordx4 %1, off\n\ts_mov_b32 m0, %0" : "=&s"(keep) : "v"(gsrc), "s"(lds_dst) : "memory"); }
__device__ __forceinline__ float max3f(float a, float b, float c) { float r; asm("v_max3_f32 %0, %1, %2, %3" : "=v"(r) : "v"(a), "v"(b), "v"(c)); return r; }
__device__ __forceinline__ float max2f(float a, float b) { float r; asm("v_max_f32_e32 %0, %1, %2" : "=v"(r) : "v"(a), "v"(b)); return r; }
__device__ __forceinline__ float fadd_s(float a, float b) { float r; asm("v_add_f32_e32 %0, %1, %2" : "=v"(r) : "v"(a), "v"(b)); return r; }
__device__ __forceinline__ float fsub_s(float a, float b) { float r; asm("v_sub_f32_e32 %0, %1, %2" : "=v"(r) : "v"(a), "v"(b)); return r; }
typedef float f32x2_t __attribute__((ext_vector_type(2))); typedef __bf16 bf16x2_t __attribute__((ext_vector_type(2)));
__device__ __forceinline__ unsigned cvtpk_s(float lo, float hi) { f32x2_t v = {lo, hi}; bf16x2_t b = __builtin_convertvector(v, bf16x2_t); return __builtin_bit_cast(unsigned, b); }
#define WAIT_BAR(N) asm volatile("s_waitcnt vmcnt(" #N ") lgkmcnt(0)\n\ts_barrier" ::: "memory")

__device__ __forceinline__ void qkt(f32x16& p0, f32x16& p1, const char* Kslot, const bf16x8* qr, const f32x16& negm, int r32, int hi) {
    const char* kb = Kslot + hi * 1024 + r32 * 16;
#pragma unroll
    for (int d0 = 0; d0 < 4; ++d0) {
        const bf16x8 b0 = *reinterpret_cast<const bf16x8*>(kb + d0 * 2048);
        const bf16x8 b1 = *reinterpret_cast<const bf16x8*>(kb + d0 * 2048 + 512);
        if (d0 == 0) { p0 = __builtin_amdgcn_mfma_f32_32x32x16_bf16(b0, qr[0], negm, 0, 0, 0); p1 = __builtin_amdgcn_mfma_f32_32x32x16_bf16(b1, qr[0], negm, 0, 0, 0); }
        else { p0 = __builtin_amdgcn_mfma_f32_32x32x16_bf16(b0, qr[d0], p0, 0, 0, 0); p1 = __builtin_amdgcn_mfma_f32_32x32x16_bf16(b1, qr[d0], p1, 0, 0, 0); } }
}
typedef __attribute__((address_space(3))) const char* lds_cptr;
typedef short v4i16_t __attribute__((ext_vector_type(4)));
__device__ __forceinline__ void kload8(bf16x8* kf, lds_cptr kp) {
    kf[0] = *(const __attribute__((address_space(3))) bf16x8*)(kp);        kf[1] = *(const __attribute__((address_space(3))) bf16x8*)(kp + 512);
    kf[2] = *(const __attribute__((address_space(3))) bf16x8*)(kp + 2048); kf[3] = *(const __attribute__((address_space(3))) bf16x8*)(kp + 2560);
    kf[4] = *(const __attribute__((address_space(3))) bf16x8*)(kp + 4096); kf[5] = *(const __attribute__((address_space(3))) bf16x8*)(kp + 4608);
    kf[6] = *(const __attribute__((address_space(3))) bf16x8*)(kp + 6144); kf[7] = *(const __attribute__((address_space(3))) bf16x8*)(kp + 6656);
}
__device__ __forceinline__ void kload2(bf16x8* kf, lds_cptr kp, int j) { kf[2 * j] = *(const __attribute__((address_space(3))) bf16x8*)(kp + j * 2048); kf[2 * j + 1] = *(const __attribute__((address_space(3))) bf16x8*)(kp + j * 2048 + 512); }
__device__ __forceinline__ s16x4 vtr(lds_cptr p) { return __builtin_bit_cast(s16x4, __builtin_amdgcn_ds_read_tr16_b64_v4i16((__attribute__((address_space(3))) v4i16_t*)p)); }
__device__ __forceinline__ float rowmax(const f32x16& p0, const f32x16& p1) {
    float a = max3f(p0[0], p0[1], p1[0]), b = max3f(p0[2], p0[3], p1[1]); a = max3f(a, p1[2], p1[3]);
#pragma unroll
    for (int r = 4; r < 16; r += 4) { a = max3f(a, p0[r], p0[r + 1]); b = max3f(b, p0[r + 2], p0[r + 3]); a = max3f(a, p1[r], p1[r + 1]); b = max3f(b, p1[r + 2], p1[r + 3]); }
    const float m = max2f(a, b);
    auto rr = __builtin_amdgcn_permlane32_swap(__float_as_uint(m), __float_as_uint(m), false, false);
    return max2f(__uint_as_float(rr[0]), __uint_as_float(rr[1]));
}
__device__ __forceinline__ void pv(f32x16* o, int vb, bf16x8 pa0, bf16x8 pa1, bf16x8 pa2, bf16x8 pa3) {
#pragma unroll
    for (int d0 = 0; d0 < 2; ++d0) { s16x4 lo[4], hi[4];
#pragma unroll
        for (int ks = 0; ks < 4; ++ks) {
            asm volatile("ds_read_b64_tr_b16 %0,%1 offset:%c2" : "=&v"(lo[ks]) : "v"(vb), "i"(d0 * 4096 + ks * 1024) : "memory");
            asm volatile("ds_read_b64_tr_b16 %0,%1 offset:%c2" : "=&v"(hi[ks]) : "v"(vb), "i"(d0 * 4096 + ks * 1024 + 512) : "memory"); }
        asm volatile("s_waitcnt lgkmcnt(0)" ::: "memory"); SBAR();
#define PK(k) (bf16x8){lo[k][0], lo[k][1], lo[k][2], lo[k][3], hi[k][0], hi[k][1], hi[k][2], hi[k][3]}
        o[d0] = __builtin_amdgcn_mfma_f32_32x32x16_bf16(pa0, PK(0), o[d0], 0, 0, 0);
        o[d0] = __builtin_amdgcn_mfma_f32_32x32x16_bf16(pa1, PK(1), o[d0], 0, 0, 0);
        o[d0] = __builtin_amdgcn_mfma_f32_32x32x16_bf16(pa2, PK(2), o[d0], 0, 0, 0);
        o[d0] = __builtin_amdgcn_mfma_f32_32x32x16_bf16(pa3, PK(3), o[d0], 0, 0, 0);
#undef PK
    }
}

struct Unit {
    int qrow0;
    int kvrow0;
    int h, kvh;
    int T0, NL;
    int tq0;
    int has_sink; float sink_l2;
};
struct MaskLane { int swa_base; int rq, rs; int c, cs; };

template <int MODE> __device__ __forceinline__ void amask(f32x16& p0, f32x16& p1, int t, const Unit& u, const MaskLane& ml, int hi, lds_cptr btab) {
    if (MODE == 0) return;
    if (t < 4) return;
    const float NEG = -INFINITY;
    if (MODE == 1) {
        const int d0 = ml.swa_base + 64 * (t - 4);
#pragma unroll
        for (int r = 0; r < 16; ++r) { const int d = d0 + (r & 3) + 8 * (r >> 2); if ((unsigned)d > 256u) p0[r] = NEG; if ((unsigned)(d + 32) > 256u) p1[r] = NEG; }
    } else {
        const int kr = u.T0 + t - 4;
        if (kr < ml.rs || kr >= ml.rs + 8) {
#pragma unroll
            for (int r = 0; r < 16; ++r) { p0[r] = NEG; p1[r] = NEG; }
        } else {
            const __attribute__((address_space(3))) float* brow = (const __attribute__((address_space(3))) float*)btab + (kr - ml.rq + 7) * 31 + (15 - ml.c + 4 * hi);
            const int k0 = 4 * hi - ml.cs;
#pragma unroll
            for (int r = 0; r < 16; ++r) { const int kk = (r & 3) + 8 * (r >> 2);
                const float b0 = brow[kk], b1 = brow[kk + 32];
                p0[r] = ((unsigned)(k0 + kk) < 16u) ? p0[r] + b0 : NEG;
                p1[r] = ((unsigned)(k0 + kk + 32) < 16u) ? p1[r] + b1 : NEG; }
        }
    }
}

template <int MODE, int KVP, int THRL>
__device__ __forceinline__ void attn_unit(const Unit& u, const bf16_t* Q, const bf16_t* __restrict__ K, const bf16_t* __restrict__ V, bf16_t* O, const float* rpb_h, char* shm) {
    const int tid = tid_opaque(), lane = tid & 63, r32 = lane & 31, hi = lane >> 5; const int wid = __builtin_amdgcn_readfirstlane(tid >> 6);
    const bf16_t* Qw = Q + (size_t)(u.qrow0 + wid * QBLK) * D + u.h * 64;
    const bf16_t* Kh = K + (size_t)u.kvrow0 * KVP + u.kvh * 64; const bf16_t* Vh = V + (size_t)u.kvrow0 * KVP + u.kvh * 64;
    const unsigned lds0 = (unsigned)(uintptr_t)shm;
    float* wsf = (float*)(shm + LDS_WS) + wid * 64;
    const bf16_t* ksrc = Kh + (long)lane * KVP + wid * 8;
    const bf16_t* vsrc = Vh + (long)(16 * (wid & 3) + (lane >> 2)) * KVP + (wid >> 2) * 32 + (lane & 3) * 8;
    const unsigned kdst = lds0 + LDS_K + wid * 1024, vdst = lds0 + LDS_V + wid * 1024;
    const int T0 = u.T0;
#define TPOS(t) ((long)(((t) < 4) ? (SEQ + 64 * (t)) : 64 * (T0 + (t) - 4)) * KVP)
#define DMA_K(t, slot) glds16(ksrc + TPOS(t), (unsigned)__builtin_amdgcn_readfirstlane(kdst + (slot)))
#define DMA_V(t, slot) glds16(vsrc + TPOS(t), (unsigned)__builtin_amdgcn_readfirstlane(vdst + (slot)))
    const int vb0 = (int)(lds0 + LDS_V) + ((lane >> 4) & 1) * 32 + (lane & 3) * 8 + (4 * hi + ((lane & 15) >> 2)) * 64;
    const char* Kbase = shm + LDS_K; bf16x8 kf[8];
    const lds_cptr shm3 = (lds_cptr)shm; const lds_cptr kp0 = shm3 + LDS_K + hi * 1024 + r32 * 16; const lds_cptr vp0 = shm3 + LDS_V + ((lane >> 4) & 1) * 32 + (lane & 3) * 8 + (4 * hi + ((lane & 15) >> 2)) * 64;
    const lds_cptr btab = shm3 + LDS_BIAS;
    const int NT = 4 + u.NL;
    DMA_K(0, 0); DMA_V(0, 0); DMA_K(1, SLOTB);
    MaskLane ml; ml.swa_base = 0; ml.rq = 0; ml.rs = 0; ml.c = 0; ml.cs = 0;
    if (MODE == 1) ml.swa_base = 64 * T0 - (u.tq0 + wid * QBLK + r32) + 128 + 4 * hi;
    if (MODE == 2) { ml.rq = (u.tq0 >> 6) + (wid >> 1); int rs = ml.rq - 4; ml.rs = rs < 0 ? 0 : (rs > 56 ? 56 : rs); ml.c = 32 * (wid & 1) + r32; int cs = ml.c - 8; ml.cs = cs < 0 ? 0 : (cs > 48 ? 48 : cs);
        if (tid < 15 * 31) ((float*)(shm + LDS_BIAS))[tid] = rpb_h[tid] * LOG2E; }
    bf16x8 qr[4];
#pragma unroll
    for (int d0 = 0; d0 < 4; ++d0) qr[d0] = *reinterpret_cast<const bf16x8*>(&Qw[(long)r32 * D + d0 * 16 + hi * 8]);
    float mhat = 0.f, l_reg = 0.f; f32x16 o[2]; o[0] = f32x16{}; o[1] = f32x16{}; f32x16 negm = f32x16{}; asm volatile("" : "+v"(negm));
#define CMASK(P0, P1, t) amask<MODE>(P0, P1, (t), u, ml, hi, btab)
    bool resc = false;
#define START(P0, P1) do { const float rm = rowmax(P0, P1); resc = false; \
    { const float dl = rm; mhat = fadd_s(mhat, dl); \
      _Pragma("unroll") for (int r = 0; r < 16; ++r) { P0[r] = fsub_s(P0[r], dl); P1[r] = fsub_s(P1[r], dl); } \
      _Pragma("unroll") for (int r = 0; r < 16; ++r) negm[r] = -mhat; asm volatile("" : "+v"(negm)); } \
    _Pragma("unroll") for (int r = 0; r < 16; ++r) P0[r] = __builtin_amdgcn_exp2f(P0[r]); } while (0)
#define RESC() do { if (resc) { asm volatile("s_waitcnt lgkmcnt(0)" ::: "memory"); \
      _Pragma("unroll") for (int d_ = 0; d_ < 2; ++d_) _Pragma("unroll") for (int r = 0; r < 16; ++r) o[d_][r] *= wsf[crow(r, hi)]; } } while (0)
    f32x16 pA0, pA1, pB0, pB1;
    int sl_prev = 0, sl_cur = 0, sl_next = SLOTB;
#define ROT() do { sl_prev = sl_cur; sl_cur = sl_next; sl_next = (sl_next == (NSLOT - 1) * SLOTB) ? 0 : sl_next + SLOTB; } while (0)
    DMA_K(2, 2 * SLOTB);
    WAIT_BAR(3);
    qkt(pA0, pA1, Kbase, qr, negm, r32, hi); asm volatile("s_nop 15\n\ts_nop 7" : "+v"(pA0), "+v"(pA1));
    START(pA0, pA1);
    _Pragma("unroll") for (int r = 0; r < 16; ++r) pA1[r] = __builtin_amdgcn_exp2f(pA1[r]);
    WAIT_BAR(0);
    DMA_K(3, 0); DMA_V(1, SLOTB);
    ROT();
    kload8(kf, kp0 + sl_cur);
    WAIT_BAR(2);
    s16x4 vlo[8], vhi[8]; u32x4 pw0, pw1, pw2, pw3;
#define PKW(P, B) cvtpk_s(P[B], P[B + 1])
#define PAF(k) __builtin_bit_cast(bf16x8, pw##k)
#define VFR(i) (bf16x8){vlo[i][0], vlo[i][1], vlo[i][2], vlo[i][3], vhi[i][0], vhi[i][1], vhi[i][2], vhi[i][3]}
#define PIN(x) asm volatile("" : "+v"(x))
#define MX3(a, b, c) __builtin_fmaxf(__builtin_fmaxf((a), (b)), (c))
#define GAPA(MF, A0, A1, A2, A3, W0, W1, PW) do { MF; sacc += A0; sacc += A1; sacc += A2; sacc += A3; PIN(sacc); W0; W1; PIN(PW); SBAR(); } while (0)
#define EX(v) __builtin_amdgcn_exp2f(v)
#define GAPB(MF, X, B) do { MF; X[B] = EX(X[B]); X[B + 1] = EX(X[B + 1]); X[B + 2] = EX(X[B + 2]); X[B + 3] = EX(X[B + 3]); PIN(X); SBAR(); } while (0)
#define VRD(i) do { vlo[i] = vtr(vp_ + (((i) >> 2) * 4096 + ((i) & 3) * 1024)); vhi[i] = vtr(vp_ + (((i) >> 2) * 4096 + ((i) & 3) * 1024 + 512)); } while (0)
#define KRD(G, j) do { if (G) { kload2(kf, kp0 + sl_next, j); SBAR(); } } while (0)
#define STEP(C0, C1, P0, P1, t, GK, GV, GL) do { SBAR(); \
    const lds_cptr vp_ = vp0 + sl_prev; \
    VRD(0); SBAR(); float sacc = (P0[0] + P0[1]); \
    GAPA(C0 = __builtin_amdgcn_mfma_f32_32x32x16_bf16(kf[0], qr[0], negm, 0, 0, 0), P0[2], P0[3], P0[4], P0[5],     pw0[0] = PKW(P0, 0), pw0[1] = PKW(P0, 2), pw0); \
    VRD(4); SBAR(); GAPA(C1 = __builtin_amdgcn_mfma_f32_32x32x16_bf16(kf[1], qr[0], negm, 0, 0, 0), P0[6], P0[7], P0[8], P0[9],     pw0[2] = PKW(P0, 4), pw0[3] = PKW(P0, 6), pw0); \
    VRD(1); SBAR(); GAPA(C0 = __builtin_amdgcn_mfma_f32_32x32x16_bf16(kf[2], qr[1], C0, 0, 0, 0),   P0[10], P0[11], P0[12], P0[13], pw1[0] = PKW(P0, 8), pw1[1] = PKW(P0, 10), pw1); \
    VRD(5); SBAR(); GAPA(C1 = __builtin_amdgcn_mfma_f32_32x32x16_bf16(kf[3], qr[1], C1, 0, 0, 0),   P0[14], P0[15], P1[0], P1[1],   pw1[2] = PKW(P0, 12), pw1[3] = PKW(P0, 14), pw1); \
    VRD(2); SBAR(); GAPA(C0 = __builtin_amdgcn_mfma_f32_32x32x16_bf16(kf[4], qr[2], C0, 0, 0, 0),   P1[2], P1[3], P1[4], P1[5],     pw2[0] = PKW(P1, 0), pw2[1] = PKW(P1, 2), pw2); \
    VRD(6); SBAR(); GAPA(C1 = __builtin_amdgcn_mfma_f32_32x32x16_bf16(kf[5], qr[2], C1, 0, 0, 0),   P1[6], P1[7], P1[8], P1[9],     pw2[2] = PKW(P1, 4), pw2[3] = PKW(P1, 6), pw2); \
    VRD(3); SBAR(); GAPA(C0 = __builtin_amdgcn_mfma_f32_32x32x16_bf16(kf[6], qr[3], C0, 0, 0, 0),   P1[10], P1[11], P1[12], P1[13], pw3[0] = PKW(P1, 8), pw3[1] = PKW(P1, 10), pw3); \
    VRD(7); SBAR(); GAPA(C1 = __builtin_amdgcn_mfma_f32_32x32x16_bf16(kf[7], qr[3], C1, 0, 0, 0),   P1[14], P1[15], 0.f, 0.f,       pw3[2] = PKW(P1, 12), pw3[3] = PKW(P1, 14), pw3); \
    l_reg += sacc; \
    if (GK) { DMA_K((t) + 3, sl_cur); } if (GV) { DMA_V((t) + 1, sl_next); } \
    CMASK(C0, C1, t); \
    { float a = MX3(C0[0], C0[1], C1[0]), b = MX3(C0[2], C0[3], C1[1]); a = MX3(a, C1[2], C1[3]); \
      _Pragma("unroll") for (int r = 4; r < 16; r += 4) { a = MX3(a, C0[r], C0[r + 1]); b = MX3(b, C0[r + 2], C0[r + 3]); a = MX3(a, C1[r], C1[r + 1]); b = MX3(b, C1[r + 2], C1[r + 3]); } \
      float rm = __builtin_fmaxf(a, b); { auto rr = __builtin_amdgcn_permlane32_swap(__float_as_uint(rm), __float_as_uint(rm), false, false); rm = __builtin_fmaxf(__uint_as_float(rr[0]), __uint_as_float(rr[1])); } \
      resc = false; \
      if (__builtin_expect(__any(rm > (float)THRL), 0)) { const float dl = __builtin_fmaxf(rm, 0.f); mhat += dl; \
        _Pragma("unroll") for (int r = 0; r < 16; ++r) { C0[r] -= dl; C1[r] -= dl; } \
        _Pragma("unroll") for (int r = 0; r < 16; ++r) negm[r] = -mhat; asm volatile("" : "+v"(negm)); \
        const float f = __builtin_amdgcn_exp2f(-dl); l_reg *= f; if (hi == 0) wsf[r32] = f; resc = true; } } \
    SBAR(); \
    GAPB(o[0] = __builtin_amdgcn_mfma_f32_32x32x16_bf16(PAF(0), VFR(0), o[0], 0, 0, 0), C0, 0); \
    GAPB(o[1] = __builtin_amdgcn_mfma_f32_32x32x16_bf16(PAF(0), VFR(4), o[1], 0, 0, 0), C0, 4); \
    KRD(GL, 0); GAPB(o[0] = __builtin_amdgcn_mfma_f32_32x32x16_bf16(PAF(1), VFR(1), o[0], 0, 0, 0), C0, 8); \
    KRD(GL, 1); GAPB(o[1] = __builtin_amdgcn_mfma_f32_32x32x16_bf16(PAF(1), VFR(5), o[1], 0, 0, 0), C0, 12); \
    KRD(GL, 2); GAPB(o[0] = __builtin_amdgcn_mfma_f32_32x32x16_bf16(PAF(2), VFR(2), o[0], 0, 0, 0), C1, 0); \
    KRD(GL, 3); GAPB(o[1] = __builtin_amdgcn_mfma_f32_32x32x16_bf16(PAF(2), VFR(6), o[1], 0, 0, 0), C1, 4); \
    GAPB(o[0] = __builtin_amdgcn_mfma_f32_32x32x16_bf16(PAF(3), VFR(3), o[0], 0, 0, 0), C1, 8); \
    GAPB(o[1] = __builtin_amdgcn_mfma_f32_32x32x16_bf16(PAF(3), VFR(7), o[1], 0, 0, 0), C1, 12); \
    } while (0)
    int t = 1;
    for (; t + 5 < NT; t += 2) {
        STEP(pB0, pB1, pA0, pA1, t, true, true, true);     WAIT_BAR(2); RESC(); ROT();
        STEP(pA0, pA1, pB0, pB1, t + 1, true, true, true); WAIT_BAR(2); RESC(); ROT();
    }
#define ENDW(tt) do { if ((tt) + 3 < NT) { WAIT_BAR(2); } else if ((tt) + 2 < NT) { WAIT_BAR(1); } else { WAIT_BAR(0); } } while (0)
    for (; t + 1 < NT; t += 2) {
        STEP(pB0, pB1, pA0, pA1, t, (t + 3 < NT), (t + 1 < NT), (t + 1 < NT));         ENDW(t);     RESC(); ROT();
        STEP(pA0, pA1, pB0, pB1, t + 1, (t + 4 < NT), (t + 2 < NT), (t + 2 < NT));     ENDW(t + 1); RESC(); ROT();
    }
    STEP(pB0, pB1, pA0, pA1, NT - 1, false, false, false); RESC();
    { float sacc = pB0[0] + pB0[1]; _Pragma("unroll") for (int r = 2; r < 16; ++r) sacc += pB0[r]; _Pragma("unroll") for (int r = 0; r < 16; ++r) sacc += pB1[r]; l_reg += sacc;
      pw0 = (u32x4){PKW(pB0, 0), PKW(pB0, 2), PKW(pB0, 4), PKW(pB0, 6)}; pw1 = (u32x4){PKW(pB0, 8), PKW(pB0, 10), PKW(pB0, 12), PKW(pB0, 14)}; pw2 = (u32x4){PKW(pB1, 0), PKW(pB1, 2), PKW(pB1, 4), PKW(pB1, 6)}; pw3 = (u32x4){PKW(pB1, 8), PKW(pB1, 10), PKW(pB1, 12), PKW(pB1, 14)};
      SBAR(); pv(o, vb0 + sl_cur, PAF(0), PAF(1), PAF(2), PAF(3)); }
#undef PKW
#undef PAF
#undef VFR
#undef PIN
#undef MX3
#undef GAPA
#undef GAPB
#undef EX
#undef VRD
#undef KRD
#undef STEP
#undef ENDW
    { auto rr = __builtin_amdgcn_permlane32_swap(__float_as_uint(l_reg), __float_as_uint(l_reg), false, false); l_reg = __uint_as_float(rr[0]) + __uint_as_float(rr[1]); }
    if (u.has_sink) l_reg += __builtin_amdgcn_exp2f(u.sink_l2 - mhat);
    if (hi == 0) wsf[32 + r32] = l_reg; asm volatile("s_waitcnt lgkmcnt(0)" ::: "memory");
    float rli[16];
#pragma unroll
    for (int r = 0; r < 16; ++r) rli[r] = __builtin_amdgcn_rcpf(wsf[32 + crow(r, hi)]);
    bf16_t* Ow = O + (size_t)(u.qrow0 + wid * QBLK) * D + u.h * 64;
    { bf16_t* stg = (bf16_t*)(shm + LDS_OST) + wid * 2048;
#pragma unroll
      for (int r = 0; r < 16; ++r) { const int orow = crow(r, hi);
#pragma unroll
          for (int d0 = 0; d0 < 2; ++d0) stg[orow * 64 + d0 * 32 + r32] = (bf16_t)f2bf(o[d0][r] * rli[r]); }
      asm volatile("s_waitcnt lgkmcnt(0)" ::: "memory");
#pragma unroll
      for (int i = 0; i < 4; ++i) { const int row = i * 8 + (lane >> 3), ch = lane & 7; const u32x4 v = *(const u32x4*)(stg + row * 64 + ch * 8); *(u32x4*)(Ow + (long)row * D + ch * 8) = v; } }
    asm volatile("s_waitcnt lgkmcnt(0)\n\ts_barrier" ::: "memory");
#undef DMA_K
#undef DMA_V
#undef TPOS
#undef CMASK
#undef START
#undef RESC
#undef ROT
}

__device__ __forceinline__ void qkt_lds(f32x16& p0, f32x16& p1, lds_cptr kb, const bf16x8* qr) {
    const f32x16 z = f32x16{};
#pragma unroll
    for (int d0 = 0; d0 < 4; ++d0) {
        const bf16x8 b0 = *(const __attribute__((address_space(3))) bf16x8*)(kb + d0 * 2048);
        const bf16x8 b1 = *(const __attribute__((address_space(3))) bf16x8*)(kb + d0 * 2048 + 512);
        if (d0 == 0) { p0 = __builtin_amdgcn_mfma_f32_32x32x16_bf16(b0, qr[0], z, 0, 0, 0); p1 = __builtin_amdgcn_mfma_f32_32x32x16_bf16(b1, qr[0], z, 0, 0, 0); }
        else { p0 = __builtin_amdgcn_mfma_f32_32x32x16_bf16(b0, qr[d0], p0, 0, 0, 0); p1 = __builtin_amdgcn_mfma_f32_32x32x16_bf16(b1, qr[d0], p1, 0, 0, 0); } }
}
template <int MODE, int KVP>
__device__ __forceinline__ void attn_unit_simple(const Unit& u, const bf16_t* Q, const bf16_t* __restrict__ K, const bf16_t* __restrict__ V, bf16_t* O, const float* rpb_h, char* shm) {
    const int tid = tid_opaque(), lane = tid & 63, r32 = lane & 31, hi = lane >> 5; const int wid = __builtin_amdgcn_readfirstlane(tid >> 6);
    const bf16_t* Qw = Q + (size_t)(u.qrow0 + wid * QBLK) * D + u.h * 64;
    const bf16_t* Kh = K + (size_t)u.kvrow0 * KVP + u.kvh * 64; const bf16_t* Vh = V + (size_t)u.kvrow0 * KVP + u.kvh * 64;
    const unsigned lds0 = (unsigned)(uintptr_t)shm;
    float* wsf = (float*)(shm + LDS_WS) + wid * 64;
    const bf16_t* ksrc = Kh + (long)lane * KVP + wid * 8;
    const bf16_t* vsrc = Vh + (long)(16 * (wid & 3) + (lane >> 2)) * KVP + (wid >> 2) * 32 + (lane & 3) * 8;
    const unsigned kdst = lds0 + LDS_K + wid * 1024, vdst = lds0 + LDS_V + wid * 1024;
    const int T0 = u.T0;
#define TPOS(t) ((long)(((t) < 4) ? (SEQ + 64 * (t)) : 64 * (T0 + (t) - 4)) * KVP)
#define DMA_K(t, slot) glds16(ksrc + TPOS(t), (unsigned)__builtin_amdgcn_readfirstlane(kdst + (slot)))
#define DMA_V(t, slot) glds16(vsrc + TPOS(t), (unsigned)__builtin_amdgcn_readfirstlane(vdst + (slot)))
    const int vb0 = (int)(lds0 + LDS_V) + ((lane >> 4) & 1) * 32 + (lane & 3) * 8 + (4 * hi + ((lane & 15) >> 2)) * 64;
    const lds_cptr shm3 = (lds_cptr)shm; const lds_cptr kp0 = shm3 + LDS_K + hi * 1024 + r32 * 16;
    const lds_cptr btab = shm3 + LDS_BIAS;
    const int NT = 4 + u.NL;
    DMA_K(0, 0); DMA_V(0, 0);
    MaskLane ml; ml.swa_base = 0; ml.rq = 0; ml.rs = 0; ml.c = 0; ml.cs = 0;
    if (MODE == 1) ml.swa_base = 64 * T0 - (u.tq0 + wid * QBLK + r32) + 128 + 4 * hi;
    if (MODE == 2) { ml.rq = (u.tq0 >> 6) + (wid >> 1); int rs = ml.rq - 4; ml.rs = rs < 0 ? 0 : (rs > 56 ? 56 : rs); ml.c = 32 * (wid & 1) + r32; int cs = ml.c - 8; ml.cs = cs < 0 ? 0 : (cs > 48 ? 48 : cs);
        if (tid < 15 * 31) ((float*)(shm + LDS_BIAS))[tid] = rpb_h[tid] * LOG2E; }
    bf16x8 qr[4];
#pragma unroll
    for (int d0 = 0; d0 < 4; ++d0) qr[d0] = *reinterpret_cast<const bf16x8*>(&Qw[(long)r32 * D + d0 * 16 + hi * 8]);
    float mhat = -INFINITY, l_reg = 0.f; f32x16 o[2]; o[0] = f32x16{}; o[1] = f32x16{};
    int slot = 0;
    for (int t = 0; t < NT; ++t) {
        asm volatile("s_waitcnt vmcnt(0) lgkmcnt(0)\n\ts_barrier" ::: "memory");
        if (t + 1 < NT) { DMA_K(t + 1, slot ^ SLOTB); DMA_V(t + 1, slot ^ SLOTB); }
        bool live = true;
        if (MODE == 1 && t >= 4) { const int klo = 64 * (T0 + t - 4), qlo = u.tq0 + wid * QBLK; live = (klo + 63 >= qlo - 128) && (klo <= qlo + 31 + 128); }
        if (MODE == 2 && t >= 4) { const int kr = T0 + t - 4; live = (kr >= ml.rs) && (kr < ml.rs + 8); }
        if (live) {
        f32x16 p0, p1;
        qkt_lds(p0, p1, kp0 + slot, qr);
        asm volatile("s_nop 15\n\ts_nop 7" : "+v"(p0), "+v"(p1));
        amask<MODE>(p0, p1, t, u, ml, hi, btab);
        float a = __builtin_fmaxf(p0[0], p1[0]);
#pragma unroll
        for (int r = 1; r < 16; ++r) a = __builtin_fmaxf(a, __builtin_fmaxf(p0[r], p1[r]));
        { auto rr = __builtin_amdgcn_permlane32_swap(__float_as_uint(a), __float_as_uint(a), false, false); a = __builtin_fmaxf(__uint_as_float(rr[0]), __uint_as_float(rr[1])); }
        const float mnew = (a > mhat + 8.0f) ? a : mhat;
        const float alpha = __builtin_amdgcn_exp2f(mhat - mnew);
        mhat = mnew;
        float sacc = 0.f;
#pragma unroll
        for (int r = 0; r < 16; ++r) { p0[r] = __builtin_amdgcn_exp2f(p0[r] - mnew); p1[r] = __builtin_amdgcn_exp2f(p1[r] - mnew); sacc += p0[r] + p1[r]; }
        l_reg = l_reg * alpha + sacc;
        if (__any(alpha != 1.0f)) {
            if (hi == 0) wsf[r32] = alpha;
            asm volatile("s_waitcnt lgkmcnt(0)" ::: "memory");
#pragma unroll
            for (int r = 0; r < 16; ++r) { const float f = wsf[crow(r, hi)]; o[0][r] *= f; o[1][r] *= f; }
        }
        u32x4 pw0, pw1, pw2, pw3;
        pw0 = (u32x4){cvtpk_s(p0[0], p0[1]), cvtpk_s(p0[2], p0[3]), cvtpk_s(p0[4], p0[5]), cvtpk_s(p0[6], p0[7])};
        pw1 = (u32x4){cvtpk_s(p0[8], p0[9]), cvtpk_s(p0[10], p0[11]), cvtpk_s(p0[12], p0[13]), cvtpk_s(p0[14], p0[15])};
        pw2 = (u32x4){cvtpk_s(p1[0], p1[1]), cvtpk_s(p1[2], p1[3]), cvtpk_s(p1[4], p1[5]), cvtpk_s(p1[6], p1[7])};
        pw3 = (u32x4){cvtpk_s(p1[8], p1[9]), cvtpk_s(p1[10], p1[11]), cvtpk_s(p1[12], p1[13]), cvtpk_s(p1[14], p1[15])};
        SBAR();
        pv(o, vb0 + slot, __builtin_bit_cast(bf16x8, pw0), __builtin_bit_cast(bf16x8, pw1), __builtin_bit_cast(bf16x8, pw2), __builtin_bit_cast(bf16x8, pw3));
        }
        slot ^= SLOTB;
    }
    { auto rr = __builtin_amdgcn_permlane32_swap(__float_as_uint(l_reg), __float_as_uint(l_reg), false, false); l_reg = __uint_as_float(rr[0]) + __uint_as_float(rr[1]); }
    if (u.has_sink) l_reg += __builtin_amdgcn_exp2f(u.sink_l2 - mhat);
    if (hi == 0) wsf[32 + r32] = l_reg; asm volatile("s_waitcnt lgkmcnt(0)" ::: "memory");
    float rli[16];
#pragma unroll
    for (int r = 0; r < 16; ++r) rli[r] = __builtin_amdgcn_rcpf(wsf[32 + crow(r, hi)]);
    bf16_t* Ow = O + (size_t)(u.qrow0 + wid * QBLK) * D + u.h * 64;
    { bf16_t* stg = (bf16_t*)(shm + LDS_OST) + wid * 2048;
#pragma unroll
      for (int r = 0; r < 16; ++r) { const int orow = crow(r, hi);
#pragma unroll
          for (int d0 = 0; d0 < 2; ++d0) stg[orow * 64 + d0 * 32 + r32] = (bf16_t)f2bf(o[d0][r] * rli[r]); }
      asm volatile("s_waitcnt lgkmcnt(0)" ::: "memory");
#pragma unroll
      for (int i = 0; i < 4; ++i) { const int row = i * 8 + (lane >> 3), ch = lane & 7; const u32x4 v = *(const u32x4*)(stg + row * 64 + ch * 8); *(u32x4*)(Ow + (long)row * D + ch * 8) = v; } }
    asm volatile("s_waitcnt lgkmcnt(0)\n\ts_barrier" ::: "memory");
#undef DMA_K
#undef DMA_V
#undef TPOS
}
#undef SBAR
#undef WAIT_BAR
}

template <int L> __device__ __forceinline__ void ph_attn_fast(const Params& P, LAS unsigned char* lds) {
    constexpr int kind = kind_of(L), kvw = kvw_of(L); constexpr bool last = (L == DEPTH - 1);
    constexpr int MODE = kind == 0 ? 2 : (kind == 1 ? 1 : 0);
    const LayerW lw = layer_w(P, L);
    const bf16_t* Qb = (const bf16_t*)(P.ws + WS_Q); const bf16_t* Kb = (const bf16_t*)(P.ws + WS_K); const bf16_t* Vb = (const bf16_t*)(P.ws + WS_V);
    bf16_t* Ob = (bf16_t*)(P.ws + WS_O);
    char* shm = (char*)lds;
    const int G = gridDim.x, bx = blockIdx.x; const int vcu = (G % 8 == 0) ? (bx % 8) * (G / 8) + bx / 8 : bx;
    for (int uix = vcu * 4; uix < 1024; uix += G * 4) {
        for (int i = 0; i < 4; ++i) {
            const int ui = uix + i, bh = ui >> 4, qb = ui & 15, b = bh >> 4, h = bh & 15;
            att::Unit u; u.qrow0 = b * SEQ + qb * 256; u.kvrow0 = b * KVROWS; u.h = h; u.kvh = kind == 0 ? h : (h >> 2); u.tq0 = qb * 256;
            u.has_sink = kind == 1 ? 1 : 0; u.sink_l2 = kind == 1 ? lw.sink[h] * LOG2E : 0.f;
            if (kind == 2) { u.T0 = 0; u.NL = 64; }
            else if (kind == 1) { const int lo = 4 * qb - 2 < 0 ? 0 : 4 * qb - 2, hi_ = 4 * qb + 6 > 64 ? 64 : 4 * qb + 6; u.T0 = lo; u.NL = hi_ - lo; }
            else { if (qb == 0) { u.T0 = 0; u.NL = 8; } else if (qb == 15) { u.T0 = 56; u.NL = 8; } else { u.T0 = 4 * qb - 4; u.NL = 12; } }
            if constexpr (MODE == 0) att::attn_unit<0, kvw, 8>(u, Qb, Kb, Vb, Ob, nullptr, shm);
            else att::attn_unit_simple<MODE, kvw>(u, Qb, Kb, Vb, Ob, kind == 0 ? lw.rpb + (size_t)h * 15 * 31 : nullptr, shm);
        }
    }
    if (!last) {
        for (int ui = vcu; ui < 64; ui += G) {
            const int b = ui >> 4, h = ui & 15;
            att::Unit u; u.qrow0 = MLAT + b * CTX; u.kvrow0 = b * KVROWS; u.h = h; u.kvh = kind == 0 ? h : (h >> 2); u.tq0 = 0; u.T0 = 0; u.NL = 0;
            u.has_sink = kind == 1 ? 1 : 0; u.sink_l2 = kind == 1 ? lw.sink[h] * LOG2E : 0.f;
            att::attn_unit<0, kvw, 8>(u, Qb, Kb, Vb, Ob, nullptr, shm);
        }
    }
}

#define XB_TMO      128
#define XB_XCNT(j)  (256  + 64 * (j))
#define XB_XSUB(j)  (1280 + 64 * (j))
#define XB_XGEN(j)  (2304 + 64 * (j))
#define XB_TOP      3328
#define XB_TOPGEN   3392
#define XCD_BAR_WORDS 3456
#define XB_SPIN_CAP (1u << 18)

__device__ __forceinline__ unsigned xb_ld(unsigned* p)              { return __hip_atomic_load(p, __ATOMIC_RELAXED, __HIP_MEMORY_SCOPE_AGENT); }
__device__ __forceinline__ unsigned xb_add(unsigned* p, unsigned v) { return __hip_atomic_fetch_add(p, v, __ATOMIC_RELAXED, __HIP_MEMORY_SCOPE_AGENT); }
__device__ __forceinline__ unsigned xb_xcc_id() { return (unsigned)__builtin_amdgcn_s_getreg((3 << 11) | 20) & 0xFu; }
#define XB_SPIN(cond, bar) do { unsigned _sp = 0; while (cond) { __builtin_amdgcn_s_sleep(1); \
    if ((++_sp & 255u) == 0u) { if (xb_ld(&(bar)[XB_TMO])) break; if (_sp > XB_SPIN_CAP) { atomicAdd(&(bar)[XB_TMO], 1u); break; } } } } while (0)

struct XcdBarrier {
    unsigned* bar; unsigned x;
    volatile LAS unsigned* st;
};

__device__ __forceinline__ XcdBarrier xcd_barrier_post(unsigned* bar, volatile LAS unsigned* st) {
    XcdBarrier b; b.bar = bar; b.x = xb_xcc_id(); b.st = st;
    if (threadIdx.x == 0) (void)xb_add(&bar[XB_XCNT(b.x)], 1u);
    return b;
}
__device__ __forceinline__ void xcd_barrier_complete(unsigned* bar, unsigned x, unsigned& nloc, unsigned& nx) {
    const unsigned G = gridDim.x * gridDim.y * gridDim.z;
    unsigned sum, cnt, mine, sp = 0u;
    for (;;) {
        sum = 0u; cnt = 0u; mine = 0u;
#pragma unroll
        for (unsigned j = 0; j < 16; ++j) { const unsigned c = xb_ld(&bar[XB_XCNT(j)]); sum += c; cnt += (c > 0u) ? 1u : 0u; mine = (j == x) ? c : mine; }
        if (sum == G) break;
        __builtin_amdgcn_s_sleep(1);
        if ((++sp & 255u) == 0u) { if (xb_ld(&bar[XB_TMO])) break; if (sp > XB_SPIN_CAP) { atomicAdd(&bar[XB_TMO], 1u); break; } }
    }
    nloc = mine > 0u ? mine : 1u; nx = cnt > 0u ? cnt : 1u;
}

__device__ __forceinline__ void xcd_barrier(const XcdBarrier& b) {
    asm volatile("s_waitcnt vmcnt(0)" ::: "memory");
    __syncthreads();
    if (threadIdx.x == 0) {
        unsigned* bar = b.bar;
        __builtin_amdgcn_s_waitcnt(0);
        unsigned nloc = b.st[0], nx = b.st[1];
        if (nloc == 0u) { xcd_barrier_complete(bar, b.x, nloc, nx); b.st[0] = nloc; b.st[1] = nx; }
        const unsigned old = xb_add(&bar[XB_XSUB(b.x)], 1u);
        const unsigned gen = old / nloc;
        if (old + 1u == (gen + 1u) * nloc) {
            __builtin_amdgcn_fence(__ATOMIC_RELEASE, "agent");
            asm volatile("s_waitcnt vmcnt(0)" ::: "memory");
            const unsigned og = xb_add(&bar[XB_TOP], 1u);
            const unsigned tg = og / nx;
            if (og + 1u == (tg + 1u) * nx) xb_add(&bar[XB_TOPGEN], 1u);
            else XB_SPIN(xb_ld(&bar[XB_TOPGEN]) == tg, bar);
            __builtin_amdgcn_fence(__ATOMIC_ACQUIRE, "agent");
            xb_add(&bar[XB_XGEN(b.x)], 1u);
            asm volatile("s_waitcnt vmcnt(0)" ::: "memory");
        } else {
            XB_SPIN(xb_ld(&bar[XB_XGEN(b.x)]) == gen, bar);
            __builtin_amdgcn_fence(__ATOMIC_ACQUIRE, "agent");
            asm volatile("s_waitcnt vmcnt(0)" ::: "memory");
        }
    }
    __syncthreads();
}

constexpr int STAGES = 6, NPHASES = 2 + DEPTH * STAGES;
constexpr int LDS_BYTES = 147456, LDS_MISC = LDS_BYTES - 64;
constexpr int CH0_ROWS = 8192;


#ifndef PROBE_KIND
#define PROBE_KIND 0
#endif
#ifndef PROBE_N
#define PROBE_N 4
#endif
#ifndef REP_SYNC
#define REP_SYNC 1
#endif
#ifndef REP_ATTN
#define REP_ATTN 1
#endif
#define PHASE(k, body) do { if (P.ph_lo <= (k) && (k) < P.ph_hi) { body; if ((k) + 1 < P.ph_hi) { for (int rs_ = 0; rs_ < REP_SYNC; ++rs_) { if ((k) == 0) grid.sync(); else xcd_barrier(bar); } } } } while (0)

template <int L> __device__ __forceinline__ void run_layer(const Params& P, cg::grid_group& grid, const XcdBarrier& bar, LAS unsigned char* lds, int wave, int lane) {
    constexpr bool last = (L == DEPTH - 1);
    constexpr int nrows = last ? MLAT : MTOT;
    constexpr int k0 = 2 + L * STAGES;
    constexpr int LN = last ? L : L + 1;
    PHASE(k0 + 0, ph_qkv_fast<L>(P, lds));
    PHASE(k0 + 1, { for (int ra_ = 0; ra_ < REP_ATTN; ++ra_) ph_attn_fast<L>(P, lds); });
    PHASE(k0 + 2, ph_resid_fast(P, L, lds, (const bf16_t*)(P.ws + WS_O), D, wt_o(P, L), 2048, nrows, P.in[7] + L * D, mod_ptr(P, L, 0) + 4096));
    PHASE(k0 + 3, ph_upconv_fast(P, L, lds, nrows));
    PHASE(k0 + 4, ph_fix(P, L, nrows));
    PHASE(k0 + 5, ph_resid_fast(P, L, lds, (const bf16_t*)(P.ws + WS_ACT), DFF, wt_dn(P, L), 5120, nrows, last ? nullptr : P.in[6] + LN * D, mod_ptr(P, LN, 0) + 1024));
}

__global__ void __launch_bounds__(NTHREADS, 2) fwd_kernel(Params P) {
    extern __shared__ __attribute__((aligned(16))) unsigned char lds_raw[];
    LAS unsigned char* lds = (LAS unsigned char*)lds_raw;
    cg::grid_group grid = cg::this_grid();
    const int wave = 0, lane = 0; (void)wave; (void)lane;
    volatile LAS unsigned* MISC = (volatile LAS unsigned*)(lds + LDS_MISC);
    { const int t0_ = tid_opaque(); if (t0_ < 16) MISC[t0_] = 0u; }
    __syncthreads();
    const XcdBarrier bar = xcd_barrier_post((unsigned*)(P.ws + WS_BAR), MISC + 8);
    PHASE(0, ph_prologue(P, lds));
    PHASE(1, ph_prologue_b(P));
    run_layer<0>(P, grid, bar, lds, wave, lane);
    run_layer<1>(P, grid, bar, lds, wave, lane);
    run_layer<2>(P, grid, bar, lds, wave, lane);
    run_layer<3>(P, grid, bar, lds, wave, lane);
#if PROBE_KIND != 0
    for (int pr_ = 0; pr_ < PROBE_N; ++pr_) {
        xcd_barrier(bar);
#if PROBE_KIND == 1
        ph_qkv_fast<0>(P, lds);
#elif PROBE_KIND == 2
        ph_qkv_fast<1>(P, lds);
#elif PROBE_KIND == 3
        ph_attn_fast<0>(P, lds);
#elif PROBE_KIND == 4
        ph_attn_fast<1>(P, lds);
#elif PROBE_KIND == 5
        ph_attn_fast<2>(P, lds);
#elif PROBE_KIND == 6
        ph_resid_fast(P, 0, lds, (const bf16_t*)(P.ws + WS_ACT), D, wt_o(P, 0), 2048, MTOT, P.in[7], mod_ptr(P, 0, 0) + 4096, true);
#elif PROBE_KIND == 7
        ph_upconv_fast(P, 0, lds, MTOT);
#elif PROBE_KIND == 8
        ph_fix(P, 0, MTOT);
#elif PROBE_KIND == 9
        ph_resid_fast(P, 0, lds, (const bf16_t*)(P.ws + WS_ACT), DFF, wt_dn(P, 0), 5120, MTOT, P.in[6] + D, mod_ptr(P, 1, 0) + 1024, true);
#endif
    }
#endif
}

extern "C" void kernel_launch(void* const* d_in, const int* in_sizes, int n_in, void* d_out, int out_size, void* d_ws, size_t ws_size, hipStream_t stream) {
    static int grid_blocks = 0;
    if (grid_blocks == 0) {
        if (n_in != 26 || out_size != MLAT * D || ws_size < WS_END) { fprintf(stderr, "kernel_launch: unexpected shapes (n_in %d out %d ws %zu)\n", n_in, out_size, ws_size); grid_blocks = -1; return; }
        int dev = 0, cus = 0, per_cu = 0;
        (void)hipGetDevice(&dev);
        (void)hipDeviceGetAttribute(&cus, hipDeviceAttributeMultiprocessorCount, dev);
        (void)hipFuncSetAttribute((const void*)fwd_kernel, hipFuncAttributeMaxDynamicSharedMemorySize, LDS_BYTES);
        (void)hipOccupancyMaxActiveBlocksPerMultiprocessor(&per_cu, (const void*)fwd_kernel, NTHREADS, LDS_BYTES);
        (void)hipGetLastError();
        if (per_cu < 1) per_cu = 1;
        grid_blocks = cus * per_cu;
        fprintf(stderr, "kernel_launch: %d CUs x %d blocks\n", cus, per_cu);
    }
    if (grid_blocks < 0) return;
    if (hipMemsetAsync(d_ws, 0, WS_CTL_BYTES, stream) != hipSuccess) { fprintf(stderr, "kernel_launch: memset failed\n"); return; }
    Params p{};
    for (int i = 0; i < 26; ++i) p.in[i] = (const float*)d_in[i];
    p.out = (float*)d_out; p.ws = (unsigned char*)d_ws; p.ph_lo = 0; p.ph_hi = NPHASES;
    void* args[] = {&p};
    hipError_t e = hipLaunchCooperativeKernel((const void*)fwd_kernel, dim3(grid_blocks), dim3(NTHREADS), args, LDS_BYTES, stream);
    if (e != hipSuccess) fprintf(stderr, "cooperative launch failed: %s (grid %d)\n", hipGetErrorString(e), grid_blocks);
}
```
